# Optimizing an MI355X kernel written in HIP

```python
import jax
import jax.numpy as jnp
from jax import lax
import numpy as np

D_MODEL = 1024
BATCH = 16
SEQ = 256
DEPTH = 2
DEC_BATCH = 8
DEC_SEQ = 2048
PAST_LEN = 256

GRID_W = 64
N_DIR = 2
A_GROUPS = 4
A_GC = 64
A_W = A_GROUPS * A_GC
CHUNK = 128
ROWS_PER_CHUNK = CHUNK // GRID_W
B_H = 6
B_DK = 64
B_DV = 64
B_W = B_H * B_DV
MLSTM_CHUNK = 64
C_H = 6
C_N = 64
C_W = C_H * C_N
DECAY_RANK = 64
ICLR_RANK = 64
GATE_RANK = 128
MIX_W = A_W + B_W + C_W
D_FF = 4 * D_MODEL
N_MOD = 6
EPS = 1e-6
HEAD_EPS = 1e-5
OFF_A = 0
OFF_QK = OFF_A + 2 * A_W
OFF_V = OFF_QK + 2 * B_H * B_DK
OFF_O = OFF_V + B_W
OFF_G = OFF_O + B_W
OFF_C = OFF_G + N_DIR * 2 * B_H
C_COLS = 3 * C_W + N_DIR * DECAY_RANK + N_DIR * ICLR_RANK + GATE_RANK
IN_COLS = OFF_C + C_COLS
C_SPLITS = [C_W, 2 * C_W, 3 * C_W, 3 * C_W + N_DIR * DECAY_RANK, 3 * C_W + N_DIR * (DECAY_RANK + ICLR_RANK)]

kernel_name = 'hybrid_gmlp_mlstm_rwkv7_diffusion_step'


def _rmsnorm(x, g):
    xf = x.astype(jnp.float32)
    y = xf * lax.rsqrt(jnp.mean(xf * xf, axis=-1, keepdims=True) + EPS)
    return (y * g.astype(jnp.float32)).astype(x.dtype)


def _head_norm(x, g, n_heads):
    shp = x.shape
    xf = x.astype(jnp.float32).reshape(shp[:-1] + (n_heads, shp[-1] // n_heads))
    mu = jnp.mean(xf, axis=-1, keepdims=True)
    var = jnp.mean(jnp.square(xf - mu), axis=-1, keepdims=True)
    y = ((xf - mu) * lax.rsqrt(var + HEAD_EPS)).reshape(shp)
    return y * g.astype(jnp.float32)


def _shift_prev(x):
    return jnp.pad(x, ((0, 0), (1, 0), (0, 0)))[:, :-1]


def _shift_next(x):
    return jnp.pad(x, ((0, 0), (0, 1), (0, 0)))[:, 1:]


def _orient(a, axis):
    return jnp.stack([a[0], jnp.flip(a[1], axis=axis - 1)])


def _chunk_gmlp(z, ln_g, w_s, b_s, n_chunks):
    bsz, t, _ = z.shape
    u, v = jnp.split(jax.nn.gelu(z), 2, axis=-1)
    v = _head_norm(v, ln_g, A_GROUPS).reshape(bsz, n_chunks, CHUNK, A_GROUPS, A_GC)
    sv = jnp.einsum('gts,bnsgc->bntgc', w_s, v) + b_s.T[:, :, None]
    y = u.reshape(sv.shape) * sv
    return y.reshape(bsz, t, A_W).astype(z.dtype)


def _mlstm_scan(q, k, v, log_i, log_f, C0, n0, m0):
    r_, b_, h_, t, _ = q.shape
    nc = t // MLSTM_CHUNK

    def chunks(a):
        a = a.reshape(a.shape[:3] + (nc, MLSTM_CHUNK) + a.shape[4:])
        return jnp.moveaxis(a, 3, 0)

    tri = jnp.tril(jnp.ones((MLSTM_CHUNK, MLSTM_CHUNK), dtype=bool))

    def step(carry, inp):
        C, n, m = carry
        qc, kc, vc, ic, fc = inp
        b = jnp.cumsum(fc, axis=-1)
        logw = jnp.where(tri, b[..., :, None] - b[..., None, :] + ic[..., None, :], -jnp.inf)
        log_inter = b + m[..., None]
        m_t = jnp.maximum(jnp.max(logw, axis=-1), log_inter)
        s = jnp.einsum('rbhtd,rbhsd->rbhts', qc, kc) * jnp.exp(logw - m_t[..., None])
        g_inter = jnp.exp(log_inter - m_t)
        num = jnp.einsum('rbhts,rbhsv->rbhtv', s, vc) + g_inter[..., None] * jnp.einsum('rbhtk,rbhkv->rbhtv', qc, C)
        den = jnp.sum(s, axis=-1) + g_inter * jnp.einsum('rbhtk,rbhk->rbht', qc, n)
        h = num / jnp.maximum(jnp.abs(den), jnp.exp(-m_t))[..., None]
        m_new = m_t[..., -1]
        w_end = jnp.exp(b[..., -1:] - b + ic - m_new[..., None])
        carry_decay = jnp.exp(b[..., -1] + m - m_new)
        C = carry_decay[..., None, None] * C + jnp.einsum('rbhs,rbhsk,rbhsv->rbhkv', w_end, kc, vc)
        n = carry_decay[..., None] * n + jnp.einsum('rbhs,rbhsk->rbhk', w_end, kc)
        return (C, n, m_new), h

    (C, n, m), hs = lax.scan(step, (C0, n0, m0), tuple(chunks(a) for a in (q, k, v, log_i, log_f)))
    hs = jnp.moveaxis(hs, 0, 3).reshape(r_, b_, h_, t, -1)
    return hs, C, n, m


def _mlstm_branch(z, conv, gate_b, out_g, C0, n0, m0):
    f32 = jnp.float32
    bsz, t, _ = z.shape
    qk = z[..., OFF_QK:OFF_V]
    qk = jax.nn.silu(_shift_prev(qk) * conv[0] + qk * conv[1] + _shift_next(qk) * conv[2])
    q, k = jnp.split(qk, 2, axis=-1)
    k = k * (B_DK ** -0.5)
    v = z[..., OFF_V:OFF_O]
    o = jax.nn.sigmoid(z[..., OFF_O:OFF_G].astype(f32))
    gates = z[..., OFF_G:OFF_C].astype(f32).reshape(bsz, t, N_DIR, 2, B_H) + gate_b.astype(f32)
    gates = _orient(jnp.moveaxis(gates, 2, 0), 2)
    log_i = jnp.swapaxes(gates[..., 0, :], 2, 3)
    log_f = jnp.swapaxes(jax.nn.log_sigmoid(gates[..., 1, :]), 2, 3)

    def heads(a, d):
        a = a.astype(f32).reshape(bsz, t, B_H, d).transpose(0, 2, 1, 3)
        return jnp.stack([a, jnp.flip(a, axis=2)])

    hs, C, n, m = _mlstm_scan(heads(q, B_DK), heads(k, B_DK), heads(v, B_DV), log_i, log_f,
                              C0.astype(f32), n0.astype(f32), m0.astype(f32))
    hs = _orient(hs, 3)
    h = (hs[0] + hs[1]).transpose(0, 2, 1, 3).reshape(bsz, t, B_W)
    return (_head_norm(h, out_g, B_H) * o).astype(z.dtype), C, n, m


def _rwkv7_scan(r, w, k, v, kk, a, S0):
    xs = tuple(jnp.moveaxis(x_, 2, 0) for x_ in (r, w, k, v, kk, a))

    def step(S, inp):
        rt, wt, kt, vt, kkt, at = inp
        sa = jnp.einsum('rbhvk,rbhk->rbhv', S, -kkt)
        S = S * wt[..., None, :] + sa[..., None] * (kkt * at)[..., None, :] + vt[..., None] * kt[..., None, :]
        return S, jnp.einsum('rbhvk,rbhk->rbhv', S, rt)

    S, ys = lax.scan(step, S0, xs)
    return jnp.moveaxis(ys, 0, 2), S


def _rwkv_branch(z, mu, w0, w2, a0, a2, g2, k_k, k_a, r_k, ln_g, S0):
    f32 = jnp.float32
    bsz, t, _ = z.shape
    zc = z[..., OFF_C:]
    zc = zc + mu * (0.5 * (_shift_prev(zc) + _shift_next(zc)) - zc)
    r, k, v, dw, da, dg = jnp.split(zc, C_SPLITS, axis=-1)
    dw = jnp.tanh(dw.reshape(bsz, t, N_DIR, DECAY_RANK))
    w_log = -jax.nn.softplus(-(w0 + jnp.einsum('btrj,rjc->btrc', dw, w2))) - 0.5
    decay = jnp.exp(-jnp.exp(w_log.astype(f32)))
    a = jax.nn.sigmoid(a0 + jnp.einsum('btrj,rjc->btrc', da.reshape(bsz, t, N_DIR, ICLR_RANK), a2))
    g = jax.nn.sigmoid(dg) @ g2
    kk = (k * k_k).astype(f32).reshape(bsz, t, C_H, C_N)
    kk = kk / jnp.maximum(jnp.linalg.norm(kk, axis=-1, keepdims=True), 1e-12)
    k_dir = k[:, :, None, :] * (1 + (a - 1) * k_a)

    def shared(x_):
        x_ = x_.astype(f32).reshape(bsz, t, C_H, C_N)
        return jnp.stack([x_, jnp.flip(x_, axis=1)])

    def per_dir(x_):
        x_ = jnp.moveaxis(x_.astype(f32), 2, 0).reshape(N_DIR, bsz, t, C_H, C_N)
        return _orient(x_, 2)

    ys, S = _rwkv7_scan(shared(r), per_dir(decay), per_dir(k_dir), shared(v), shared(kk), per_dir(a), S0.astype(f32))
    ys = _orient(ys, 2)
    y = _head_norm((ys[0] + ys[1]).reshape(bsz, t, C_W), ln_g, C_H)
    bonus = jnp.sum((r[:, :, None, :] * k_dir * r_k).astype(f32).reshape(bsz, t, N_DIR, C_H, C_N), axis=(2, 4))
    y = y + (bonus[..., None] * v.astype(f32).reshape(bsz, t, C_H, C_N)).reshape(bsz, t, C_W)
    return (y * g.astype(f32)).astype(z.dtype), S


def _layer(x, cond, n_chunks, lp, C0, n0, m0, S0):
    mod = jax.nn.silu(cond) @ lp['w_mod'] + lp['b_mod']
    sh1, sc1, g1, sh2, sc2, g2 = jnp.split(mod[:, None, :], N_MOD, axis=-1)
    h = _rmsnorm(x, lp['norm1_g']) * (1 + sc1) + sh1
    z = h @ lp['w_in']
    y_a = _chunk_gmlp(z[..., OFF_A:OFF_QK], lp['gmlp_ln_g'], lp['gmlp_w_s'], lp['gmlp_b_s'], n_chunks)
    y_b, C, n, m = _mlstm_branch(z, lp['mlstm_conv'], lp['mlstm_gate_b'], lp['mlstm_out_g'], C0, n0, m0)
    y_c, S = _rwkv_branch(z, lp['rwkv_mu'], lp['rwkv_w0'], lp['rwkv_w2'], lp['rwkv_a0'], lp['rwkv_a2'],
                          lp['rwkv_g2'], lp['rwkv_k_k'], lp['rwkv_k_a'], lp['rwkv_r_k'], lp['rwkv_ln_g'], S0)
    x = x + g1 * (jnp.concatenate([y_a, y_b, y_c], axis=-1) @ lp['w_out'])
    h = _rmsnorm(x, lp['norm2_g']) * (1 + sc2) + sh2
    x = x + g2 * (jnp.square(jax.nn.relu(h @ lp['mlp_w1'])) @ lp['mlp_w2'])
    return x, C, n, m, S


def setup_inputs(seed: int = 0) -> dict:
    key = jax.random.key(seed)
    ks = iter(jax.random.split(key, 48))

    def nrm(shape, s):
        return jax.random.normal(next(ks), shape, jnp.float32) * s

    def uni(shape, lo, hi):
        return jax.random.uniform(next(ks), shape, jnp.float32, lo, hi)

    f_bias = jnp.broadcast_to(jnp.linspace(3.0, 6.0, B_H), (DEPTH, N_DIR, B_H))
    gate_b = jnp.stack([nrm((DEPTH, N_DIR, B_H), 0.1), f_bias + nrm((DEPTH, N_DIR, B_H), 0.1)], axis=2)
    conv_center = jnp.array([0.0, 1.0, 0.0], jnp.float32)[None, :, None]
    return {
        'x_prompt': nrm((BATCH, SEQ, D_MODEL), 1.0),
        'x_sample': nrm((DEC_BATCH, DEC_SEQ, D_MODEL), 1.0),
        'c': nrm((DEC_BATCH, D_MODEL), 1.0),
        'state_mlstm_C': nrm((DEC_BATCH, DEPTH, N_DIR, B_H, B_DK, B_DV), 0.3),
        'state_mlstm_n': nrm((DEC_BATCH, DEPTH, N_DIR, B_H, B_DK), 0.3),
        'state_mlstm_m': 2.0 + nrm((DEC_BATCH, DEPTH, N_DIR, B_H), 0.5),
        'state_rwkv_S': nrm((DEC_BATCH, DEPTH, N_DIR, C_H, C_N, C_N), 0.3),
        'c_ctx': nrm((D_MODEL,), 1.0),
        'norm1_g': 1.0 + nrm((DEPTH, D_MODEL), 0.05),
        'norm2_g': 1.0 + nrm((DEPTH, D_MODEL), 0.05),
        'w_mod': nrm((DEPTH, D_MODEL, N_MOD * D_MODEL), 0.5 * D_MODEL ** -0.5),
        'b_mod': nrm((DEPTH, N_MOD * D_MODEL), 0.02),
        'w_in': nrm((DEPTH, D_MODEL, IN_COLS), D_MODEL ** -0.5),
        'w_out': nrm((DEPTH, MIX_W, D_MODEL), MIX_W ** -0.5),
        'gmlp_ln_g': 1.0 + nrm((DEPTH, A_W), 0.05),
        'gmlp_w_s': nrm((DEPTH, A_GROUPS, CHUNK, CHUNK), CHUNK ** -0.5),
        'gmlp_b_s': 1.0 + nrm((DEPTH, A_GROUPS, CHUNK), 0.1),
        'mlstm_conv': conv_center + nrm((DEPTH, 3, 2 * B_H * B_DK), 0.3),
        'mlstm_gate_b': gate_b,
        'mlstm_out_g': 1.0 + nrm((DEPTH, B_W), 0.05),
        'rwkv_mu': uni((DEPTH, C_COLS), 0.0, 1.0),
        'rwkv_w0': uni((DEPTH, N_DIR, C_W), -4.0, 1.0),
        'rwkv_w2': nrm((DEPTH, N_DIR, DECAY_RANK, C_W), 0.1),
        'rwkv_a0': nrm((DEPTH, N_DIR, C_W), 0.5),
        'rwkv_a2': nrm((DEPTH, N_DIR, ICLR_RANK, C_W), 0.1),
        'rwkv_g2': nrm((DEPTH, GATE_RANK, C_W), GATE_RANK ** -0.5),
        'rwkv_k_k': 0.85 + nrm((DEPTH, C_W), 0.05),
        'rwkv_k_a': 1.0 + nrm((DEPTH, C_W), 0.05),
        'rwkv_r_k': nrm((DEPTH, C_W), 0.1),
        'rwkv_ln_g': 1.0 + nrm((DEPTH, C_W), 0.05),
        'mlp_w1': nrm((DEPTH, D_MODEL, D_FF), D_MODEL ** -0.5),
        'mlp_w2': nrm((DEPTH, D_FF, D_MODEL), D_FF ** -0.5),
        'final_g': 1.0 + nrm((D_MODEL,), 0.05),
    }


def reference(x_prompt, x_sample, c, state_mlstm_C, state_mlstm_n, state_mlstm_m, state_rwkv_S, c_ctx,
              norm1_g, norm2_g, w_mod, b_mod, w_in, w_out, gmlp_ln_g, gmlp_w_s, gmlp_b_s,
              mlstm_conv, mlstm_gate_b, mlstm_out_g, rwkv_mu, rwkv_w0, rwkv_w2, rwkv_a0, rwkv_a2,
              rwkv_g2, rwkv_k_k, rwkv_k_a, rwkv_r_k, rwkv_ln_g, mlp_w1, mlp_w2, final_g):
    f32 = jnp.float32
    n_prompt = x_prompt.shape[0]
    ctx_chunks = x_prompt.shape[1] // CHUNK
    rows = x_sample.shape[1] // GRID_W
    lat_chunks = rows // ROWS_PER_CHUNK
    cond_ctx = c_ctx[None, :]
    xp, xs = x_prompt, x_sample
    new_C, new_n, new_m, new_S = [], [], [], []
    for l in range(DEPTH):
        lp = {
            'norm1_g': norm1_g[l], 'norm2_g': norm2_g[l], 'w_mod': w_mod[l], 'b_mod': b_mod[l],
            'w_in': w_in[l], 'w_out': w_out[l], 'gmlp_ln_g': gmlp_ln_g[l], 'gmlp_w_s': gmlp_w_s[l],
            'gmlp_b_s': gmlp_b_s[l], 'mlstm_conv': mlstm_conv[l], 'mlstm_gate_b': mlstm_gate_b[l],
            'mlstm_out_g': mlstm_out_g[l], 'rwkv_mu': rwkv_mu[l], 'rwkv_w0': rwkv_w0[l],
            'rwkv_w2': rwkv_w2[l], 'rwkv_a0': rwkv_a0[l], 'rwkv_a2': rwkv_a2[l], 'rwkv_g2': rwkv_g2[l],
            'rwkv_k_k': rwkv_k_k[l], 'rwkv_k_a': rwkv_k_a[l], 'rwkv_r_k': rwkv_r_k[l],
            'rwkv_ln_g': rwkv_ln_g[l], 'mlp_w1': mlp_w1[l], 'mlp_w2': mlp_w2[l],
        }
        xp, C, n, m, S = _layer(
            xp, cond_ctx, ctx_chunks, lp,
            jnp.zeros((N_DIR, n_prompt, B_H, B_DK, B_DV), f32),
            jnp.zeros((N_DIR, n_prompt, B_H, B_DK), f32),
            jnp.zeros((N_DIR, n_prompt, B_H), f32),
            jnp.zeros((N_DIR, n_prompt, C_H, C_N, C_N), f32))
        new_C.append(jnp.swapaxes(C, 0, 1))
        new_n.append(jnp.swapaxes(n, 0, 1))
        new_m.append(jnp.swapaxes(m, 0, 1))
        new_S.append(jnp.swapaxes(S, 0, 1))
        xs, _, _, _, _ = _layer(
            xs, c, lat_chunks, lp,
            jnp.swapaxes(state_mlstm_C[:, l], 0, 1),
            jnp.swapaxes(state_mlstm_n[:, l], 0, 1),
            jnp.swapaxes(state_mlstm_m[:, l], 0, 1),
            jnp.swapaxes(state_rwkv_S[:, l], 0, 1))
    y_prompt = _rmsnorm(xp, final_g)
    y_sample = _rmsnorm(xs, final_g)
    return (y_prompt, y_sample, jnp.stack(new_C, axis=1), jnp.stack(new_n, axis=1),
            jnp.stack(new_m, axis=1), jnp.stack(new_S, axis=1))
```

```cpp
#include <hip/hip_runtime.h>
#include <cstdio>
#include <cstdint>

#ifndef MK_SINGLE
#define MK_SINGLE 1
#endif

#define LAS __attribute__((address_space(3)))
#define GAS __attribute__((address_space(1)))
typedef unsigned short bf16;
typedef float f32x4 __attribute__((ext_vector_type(4)));
typedef float f32x2 __attribute__((ext_vector_type(2)));
typedef unsigned u32x4 __attribute__((ext_vector_type(4)));
typedef unsigned u32x2 __attribute__((ext_vector_type(2)));
typedef short bf16x8 __attribute__((ext_vector_type(8)));

constexpr int D = 1024, MCTX = 4096, TCTX = 256, TLAT = 2048, M = 20480, DEPTH = 2, NMODC = 9;
constexpr int INC = 3608, ZP = 3840, FF = 4096;
constexpr int OFF_QK = 512, OFF_V = 1280, OFF_O = 1664, OFF_G = 2048, OFF_C = 2072;
constexpr int YB_OFF = 256, YC_OFF = 640;
constexpr int NWAVES = 8, NTHR = 512;

constexpr size_t MiB = 1u << 20;
constexpr size_t WS_CTL = 0, CTL_ZERO_BYTES = 1 * MiB;
constexpr size_t WS_MOD = 1 * MiB;
constexpr size_t WS_BON = 2 * MiB;
constexpr size_t WS_W = 4 * MiB;
constexpr size_t WOFF_IN = 0, WOFF_OUT = (size_t)ZP * D * 2, WOFF_W1 = WOFF_OUT + (size_t)D * D * 2, WOFF_W2 = WOFF_W1 + (size_t)FF * D * 2;
constexpr size_t WS_ACT = 30 * MiB;
constexpr size_t WS_Z = 70 * MiB;
constexpr size_t WS_YS = 220 * MiB;
constexpr size_t WS_END = 250 * MiB;
static_assert(WS_W + WOFF_W2 + (size_t)D * FF * 2 <= WS_ACT, "weights");
static_assert(WS_ACT + (size_t)M * D * 2 <= WS_Z && WS_Z + (size_t)M * ZP * 2 <= WS_YS && WS_YS + (size_t)2 * M * 384 * 2 <= WS_END && WS_Z + (size_t)M * FF * 2 <= WS_END, "ws map");
constexpr int CW_WORK = 64;
constexpr int CW_BAR = 4096;
constexpr int LDS_BYTES = 163840;
constexpr int MISC_OFF = 160 * 1024 - 256;

__device__ __forceinline__ float bf2f(unsigned short u) { return __uint_as_float((unsigned)u << 16); }
typedef __bf16 bf16x2_t __attribute__((ext_vector_type(2)));
__device__ __forceinline__ unsigned pk2(float lo, float hi) { const f32x2 v = {lo, hi}; return __builtin_bit_cast(unsigned, __builtin_convertvector(v, bf16x2_t)); }
__device__ __forceinline__ unsigned f2bf(float f) { return pk2(f, 0.f) & 0xffffu; }
__device__ __forceinline__ void ld8(const bf16* p, float (&v)[8]) {
    const u32x4 w = *(const u32x4*)p;
    v[0] = __uint_as_float(w.x << 16); v[1] = __uint_as_float(w.x & 0xffff0000u); v[2] = __uint_as_float(w.y << 16); v[3] = __uint_as_float(w.y & 0xffff0000u);
    v[4] = __uint_as_float(w.z << 16); v[5] = __uint_as_float(w.z & 0xffff0000u); v[6] = __uint_as_float(w.w << 16); v[7] = __uint_as_float(w.w & 0xffff0000u);
}
__device__ __forceinline__ void st8(bf16* p, const float (&v)[8]) {
    u32x4 w; w.x = pk2(v[0], v[1]); w.y = pk2(v[2], v[3]); w.z = pk2(v[4], v[5]); w.w = pk2(v[6], v[7]); *(u32x4*)p = w;
}
__device__ __forceinline__ void ldf8(const float* p, float (&v)[8]) { const f32x4 a = *(const f32x4*)p, b = *(const f32x4*)(p + 4); v[0] = a.x; v[1] = a.y; v[2] = a.z; v[3] = a.w; v[4] = b.x; v[5] = b.y; v[6] = b.z; v[7] = b.w; }
__device__ __forceinline__ float sigmoidf_(float x) { return 1.0f / (1.0f + __expf(-x)); }
__device__ __forceinline__ float siluf_(float x) { return x / (1.0f + __expf(-x)); }
__device__ __forceinline__ float logsigf_(float x) { return fminf(x, 0.0f) - __logf(1.0f + __expf(-fabsf(x))); }
__device__ __forceinline__ float tanhf_(float x) { return 1.0f - 2.0f / (1.0f + __expf(2.0f * x)); }
__device__ __forceinline__ float geluf_(float x) { return 0.5f * x * (1.0f + tanhf_(0.7978845608028654f * (x + 0.044715f * x * x * x))); }
#define DPPX(x, ctrl) __uint_as_float(__builtin_amdgcn_update_dpp(0u, __float_as_uint(x), ctrl, 0xf, 0xf, true))
__device__ __forceinline__ float bperm(float v, int srclane) { return __uint_as_float((unsigned)__builtin_amdgcn_ds_bpermute(srclane << 2, (int)__float_as_uint(v))); }
__device__ __forceinline__ float sum4(float v) { v += DPPX(v, 0xB1); v += DPPX(v, 0x4E); return v; }
__device__ __forceinline__ float sum8(float v) { v += DPPX(v, 0xB1); v += DPPX(v, 0x4E); v += DPPX(v, 0x141); return v; }
__device__ __forceinline__ float wave_sum(float v, int lane) {
    v += DPPX(v, 0xB1); v += DPPX(v, 0x4E); v += DPPX(v, 0x141); v += DPPX(v, 0x140);
    v += bperm(v, lane ^ 16); v += bperm(v, lane ^ 32);
    return v;
}
__device__ __forceinline__ float dpp_sum16(float x) {
    x += __uint_as_float(__builtin_amdgcn_update_dpp(0u, __float_as_uint(x), 0xB1, 0xf, 0xf, true));
    x += __uint_as_float(__builtin_amdgcn_update_dpp(0u, __float_as_uint(x), 0x4E, 0xf, 0xf, true));
    x += __uint_as_float(__builtin_amdgcn_update_dpp(0u, __float_as_uint(x), 0x141, 0xf, 0xf, true));
    x += __uint_as_float(__builtin_amdgcn_update_dpp(0u, __float_as_uint(x), 0x140, 0xf, 0xf, true));
    return x;
}

namespace pg8 {
#define PG8_LAS __attribute__((address_space(3)))
typedef unsigned short bf16_t;
constexpr int BM = 256, BK = 64, HALF = 128, HTB = HALF * BK * 2, STAGE_BYTES = 8 * HTB, NXCD = 8, WGM = 8;
__host__ __device__ __forceinline__ int lds_byte(int r, int c) { const int st = (r >> 4) * 2 + (c >> 5), rr = r & 15, cc = c & 31, ob = rr * 64 + cc * 2; return st * 1024 + (ob ^ (((ob >> 9) & 1) << 5)); }
__host__ __device__ __forceinline__ void stage_rc(int b, int& R, int& C) { const int st = b / 1024, sb = b % 1024, swz = sb ^ (((sb >> 9) & 1) << 5); R = (st >> 1) * 16 + swz / 64; C = (st & 1) * 32 + (swz % 64) / 2; }
__host__ __device__ __forceinline__ int perm32(int rho) { const int n = rho >> 4, i = rho & 15; return 8 * (i >> 2) + 4 * n + (i & 3); }
struct Unit { int pm, pn; };
struct Gemm { const bf16_t* A; const bf16_t* Bt; int M, N, K, lda; };
struct StaticOrder {
    int nM, nN, nwg, G, c;
    __host__ __device__ void init(int M_, int N_, int G_, int c_) { nM = M_ / BM; nN = N_ / BM; nwg = nM * nN; G = G_; c = c_; }
    __host__ __device__ bool next(int i, Unit& u) const {
        const long L = (long)i * G + c; if (L >= nwg) return false;
        int wgid = (int)L; { const int q = nwg / NXCD, r = nwg % NXCD, xcd = wgid % NXCD, off = wgid / NXCD; wgid = (xcd < r ? xcd * (q + 1) : r * (q + 1) + (xcd - r) * q) + off; }
        const int nig = WGM * nN, gid = wgid / nig, fm = gid * WGM, gsz = (nM - fm) < WGM ? (nM - fm) : WGM;
        u.pm = fm + ((wgid % nig) % gsz); u.pn = (wgid % nig) / gsz; return true;
    }
    __device__ __forceinline__ void a_ready(const Unit&) const {}
    __device__ __forceinline__ void done(const Unit&) const {}
};
__device__ __forceinline__ unsigned cvt_pk_bf16(float lo, float hi) { unsigned r; asm volatile("v_cvt_pk_bf16_f32 %0, %1, %2" : "=v"(r) : "v"(lo), "v"(hi)); return r; }

template <int ACT  > struct EpiBf16 {
    static constexpr bool PERM = true, AFTER_DRAIN = false;
    bf16_t* O; int ldc;
    __device__ __forceinline__ void operator()(const f32x4 (&acc)[2][2][4][2], const Unit& u, int wr, int wc, int fr, int fq) const {
        const int row0 = u.pm * BM + wr * 64 + fr, col0 = u.pn * BM + wc * 32 + 8 * fq;
#pragma unroll
        for (int ai = 0; ai < 2; ++ai)
#pragma unroll
            for (int m = 0; m < 4; ++m) { bf16_t* rowp = O + (size_t)(row0 + ai * HALF + m * 16) * ldc + col0;
#pragma unroll
                for (int bj = 0; bj < 2; ++bj) { f32x4 v0 = acc[ai][bj][m][0], v1 = acc[ai][bj][m][1];
                    if (ACT == 2) {
#pragma unroll
                        for (int e = 0; e < 4; ++e) { const float a = fmaxf(v0[e], 0.f), b = fmaxf(v1[e], 0.f); v0[e] = a * a; v1[e] = b * b; } }
                    u32x4 w; w.x = cvt_pk_bf16(v0[0], v0[1]); w.y = cvt_pk_bf16(v0[2], v0[3]); w.z = cvt_pk_bf16(v1[0], v1[1]); w.w = cvt_pk_bf16(v1[2], v1[3]);
                    *(u32x4*)(rowp + bj * HALF) = w; } }
    }
};
struct EpiRes {
    static constexpr bool PERM = false, AFTER_DRAIN = false;
    const float* xin_c; const float* xin_l; float* xout; const float* gate; int pm0;
    __device__ __forceinline__ void operator()(const f32x4 (&acc)[2][2][4][2], const Unit& u, int wr, int wc, int fr, int fq) const {
        const int pm = u.pm + pm0, ci = pm < 16 ? 0 : 1 + ((pm - 16) >> 3);
        const float* xi = pm < 16 ? xin_c + (size_t)pm * 256 * D : xin_l + (size_t)(pm - 16) * 256 * D;
        float* xo = xout + (size_t)pm * 256 * D;
        const int rl0 = wr * 64 + fr, col0 = u.pn * BM + wc * 32 + 4 * fq;
        f32x4 gv[2][2];
#pragma unroll
        for (int bj = 0; bj < 2; ++bj)
#pragma unroll
            for (int n = 0; n < 2; ++n) gv[bj][n] = *(const f32x4*)(gate + ci * 6144 + col0 + bj * HALF + n * 16);
#pragma unroll
        for (int ai = 0; ai < 2; ++ai)
#pragma unroll
            for (int m = 0; m < 4; ++m) { const size_t ro = (size_t)(rl0 + ai * HALF + m * 16) * D + col0;
#pragma unroll
                for (int bj = 0; bj < 2; ++bj)
#pragma unroll
                    for (int n = 0; n < 2; ++n) { const size_t off = ro + bj * HALF + n * 16; const f32x4 xv = *(const f32x4*)(xi + off); *(f32x4*)(xo + off) = xv + gv[bj][n] * acc[ai][bj][m][n]; }
                if (m & 1) asm volatile("" ::: "memory"); }
    }
};

template <class Epi, class Sched, bool ALIGN_EPI = false, bool SP2 = false>
__device__ __forceinline__ void gemm_phase(PG8_LAS unsigned char* lds, const Gemm g, const Sched& S, const Epi& E, const int tid) {
    const int wid = __builtin_amdgcn_readfirstlane(tid >> 6), lane = tid & 63, wr = wid >> 2, wc = wid & 3, fr = lane & 15, fq = lane >> 4;
    const int K = g.K, nt = K / BK, lda = g.lda;
    unsigned voffA[2], voffB[2];
#pragma unroll
    for (int i = 0; i < 2; ++i) { int R, C; stage_rc(tid * 16 + i * 8192, R, C); const int Rb = Epi::PERM ? ((R & ~31) + perm32(R & 31)) : R;
        voffA[i] = (unsigned)(R * lda + C) * 2u; voffB[i] = (unsigned)(Rb * K + C) * 2u; }
    const size_t kstep = (size_t)(BK * 2);
    const size_t hstepA = (size_t)HALF * lda * 2, hstepB = (size_t)HALF * K * 2;
    const size_t tstepA = 2 * hstepA, tstepB = 2 * hstepB;
    const unsigned ldsw = (unsigned)wid * 1024u;
    const int aoff = lds_byte(wr * 64 + fr, fq * 8), boff = lds_byte(wc * 32 + fr, fq * 8);
#define PG8_SA(b, h) (((b) * 2 + (h)) * HTB)
#define PG8_SB(b, h) ((4 + (b) * 2 + (h)) * HTB)
#define PG8_STAGE(bufoff, gbase, voff) do { _Pragma("unroll") for (int _i = 0; _i < 2; ++_i) \
        __builtin_amdgcn_global_load_lds((const unsigned*)((const char*)(gbase) + (voff)[_i]), (PG8_LAS unsigned*)(lds + (bufoff) + ldsw + _i * 8192), 16, 0, 0); } while (0)
#define PG8_LDA(dst, b, h) do { _Pragma("unroll") for (int m = 0; m < 4; ++m) _Pragma("unroll") for (int k = 0; k < 2; ++k) dst[m][k] = *(const PG8_LAS bf16x8*)(lds + PG8_SA(b, h) + aoff + m * 2048 + k * 1024); } while (0)
#define PG8_LDB(dst, b, h) do { _Pragma("unroll") for (int n = 0; n < 2; ++n) _Pragma("unroll") for (int k = 0; k < 2; ++k) dst[n][k] = *(const PG8_LAS bf16x8*)(lds + PG8_SB(b, h) + boff + n * 2048 + k * 1024); } while (0)
#define PG8_MMA(ai, bj, At, Bt) do { __builtin_amdgcn_s_setprio(1); _Pragma("unroll") for (int m = 0; m < 4; ++m) _Pragma("unroll") for (int n = 0; n < 2; ++n) _Pragma("unroll") for (int k = 0; k < 2; ++k) \
        acc[ai][bj][m][n] = __builtin_amdgcn_mfma_f32_16x16x32_bf16(Bt[n][k], At[m][k], acc[ai][bj][m][n], 0, 0, 0); __builtin_amdgcn_s_setprio(0); } while (0)
#define PG8_WAIT_V(n) asm volatile("s_waitcnt vmcnt(" #n ")" ::: "memory")
#define PG8_WAIT_L(n) asm volatile("s_waitcnt lgkmcnt(" #n ")" ::: "memory")
#define PG8_BAR __builtin_amdgcn_s_barrier()
#define PG8_SCHED __builtin_amdgcn_sched_barrier(0)
    Unit cur, nxt; int ui = 0;
    if (!S.next(0, cur)) return;
    f32x4 acc[2][2][4][2];
#pragma unroll
    for (int a = 0; a < 2; ++a)
#pragma unroll
        for (int b = 0; b < 2; ++b)
#pragma unroll
            for (int m = 0; m < 4; ++m)
#pragma unroll
                for (int n = 0; n < 2; ++n) acc[a][b][m][n] = (f32x4){0.f, 0.f, 0.f, 0.f};
    bf16x8 At[4][2], B0[2][2], B1[2][2];
    const char* cA = (const char*)g.A + (size_t)cur.pm * tstepA; const char* cB = (const char*)g.Bt + (size_t)cur.pn * tstepB;
    S.a_ready(cur);
    if constexpr (SP2) {
        PG8_STAGE(PG8_SB(0, 0), cB, voffB); PG8_STAGE(PG8_SB(0, 1), cB + hstepB, voffB); PG8_STAGE(PG8_SA(0, 0), cA, voffA); PG8_STAGE(PG8_SA(0, 1), cA + hstepA, voffA);
        if (wr == 1) PG8_BAR;
        PG8_WAIT_V(2); PG8_BAR;
        PG8_STAGE(PG8_SB(1, 0), cB + kstep, voffB); PG8_STAGE(PG8_SA(1, 0), cA + kstep, voffA); PG8_STAGE(PG8_SB(1, 1), cB + hstepB + kstep, voffB);
        PG8_WAIT_V(6); PG8_BAR;
    } else {
        PG8_STAGE(PG8_SB(0, 0), cB, voffB); PG8_STAGE(PG8_SA(0, 0), cA, voffA); PG8_STAGE(PG8_SB(0, 1), cB + hstepB, voffB); PG8_STAGE(PG8_SA(0, 1), cA + hstepA, voffA);
        if (wr == 1) PG8_BAR;
        PG8_WAIT_V(4); PG8_BAR;
        PG8_STAGE(PG8_SB(1, 0), cB + kstep, voffB); PG8_STAGE(PG8_SA(1, 0), cA + kstep, voffA); PG8_STAGE(PG8_SB(1, 1), cB + hstepB + kstep, voffB);
        PG8_WAIT_V(6); PG8_BAR;
    }
    for (;;) {
        const bool has_next = S.next(ui + 1, nxt);
        const char* nA = has_next ? (const char*)g.A + (size_t)nxt.pm * tstepA : cA; const char* nB = has_next ? (const char*)g.Bt + (size_t)nxt.pn * tstepB : cB;
        for (int t = 0; t < nt; t += 2) {
            const bool last = (t == nt - 2);
            const char* a1 = cA + (size_t)(t + 1) * kstep;
            const char* a2 = last ? nA : cA + (size_t)(t + 2) * kstep; const char* b2 = last ? nB : cB + (size_t)(t + 2) * kstep;
            const char* a3 = a2 + kstep; const char* b3 = b2 + kstep;
            if (last && has_next) S.a_ready(nxt);
            if constexpr (SP2) {
            PG8_LDB(B0, 0, 0); PG8_LDB(B1, 0, 1); PG8_SCHED; PG8_LDA(At, 0, 0); PG8_STAGE(PG8_SA(1, 1), a1 + hstepA, voffA);
            PG8_WAIT_V(8); PG8_WAIT_L(0); PG8_BAR; PG8_MMA(0, 0, At, B0); PG8_MMA(0, 1, At, B1); PG8_BAR; PG8_SCHED;
            PG8_LDA(At, 0, 1); PG8_STAGE(PG8_SB(0, 0), b2, voffB); PG8_STAGE(PG8_SB(0, 1), b2 + hstepB, voffB); PG8_STAGE(PG8_SA(0, 0), a2, voffA);
            PG8_WAIT_V(8); PG8_WAIT_L(0); PG8_BAR; PG8_MMA(1, 0, At, B0); PG8_MMA(1, 1, At, B1); PG8_BAR; PG8_SCHED;
            PG8_LDB(B0, 1, 0); PG8_LDB(B1, 1, 1); PG8_SCHED; PG8_LDA(At, 1, 0); PG8_STAGE(PG8_SA(0, 1), a2 + hstepA, voffA);
            PG8_WAIT_V(8); PG8_WAIT_L(0); PG8_BAR; PG8_MMA(0, 0, At, B0); PG8_MMA(0, 1, At, B1); PG8_BAR; PG8_SCHED;
            PG8_LDA(At, 1, 1); PG8_STAGE(PG8_SB(1, 0), b3, voffB); PG8_STAGE(PG8_SB(1, 1), b3 + hstepB, voffB); PG8_STAGE(PG8_SA(1, 0), a3, voffA);
            PG8_WAIT_V(8); PG8_WAIT_L(0); PG8_BAR; PG8_MMA(1, 0, At, B0); PG8_MMA(1, 1, At, B1); PG8_BAR; PG8_SCHED;
            } else {
            PG8_LDB(B0, 0, 0); PG8_SCHED; PG8_LDA(At, 0, 0); PG8_STAGE(PG8_SA(1, 1), a1 + hstepA, voffA);
            PG8_WAIT_L(8); PG8_BAR; PG8_WAIT_L(0); PG8_MMA(0, 0, At, B0); PG8_BAR; PG8_SCHED;
            PG8_LDB(B1, 0, 1); PG8_STAGE(PG8_SB(0, 0), b2, voffB);
            PG8_BAR; PG8_WAIT_L(0); PG8_MMA(0, 1, At, B1); PG8_BAR;
            PG8_LDA(At, 0, 1); PG8_STAGE(PG8_SA(0, 0), a2, voffA);
            PG8_BAR; PG8_WAIT_L(0); PG8_MMA(1, 0, At, B0); PG8_BAR; PG8_SCHED;
            PG8_STAGE(PG8_SB(0, 1), b2 + hstepB, voffB);
            PG8_WAIT_V(6); PG8_BAR; PG8_MMA(1, 1, At, B1); PG8_BAR;
            PG8_LDB(B0, 1, 0); PG8_SCHED; PG8_LDA(At, 1, 0); PG8_STAGE(PG8_SA(0, 1), a2 + hstepA, voffA);
            PG8_WAIT_L(8); PG8_BAR; PG8_WAIT_L(0); PG8_MMA(0, 0, At, B0); PG8_BAR; PG8_SCHED;
            PG8_LDB(B1, 1, 1); PG8_STAGE(PG8_SB(1, 0), b3, voffB);
            PG8_BAR; PG8_WAIT_L(0); PG8_MMA(0, 1, At, B1); PG8_BAR;
            PG8_LDA(At, 1, 1); PG8_STAGE(PG8_SA(1, 0), a3, voffA);
            PG8_BAR; PG8_WAIT_L(0); PG8_MMA(1, 0, At, B0); PG8_BAR; PG8_SCHED;
            PG8_STAGE(PG8_SB(1, 1), b3 + hstepB, voffB);
            PG8_WAIT_V(6); PG8_BAR; PG8_MMA(1, 1, At, B1); PG8_BAR;
            }
        }
        if constexpr (ALIGN_EPI) { if (wr == 0) PG8_BAR; }
        if constexpr (!Epi::AFTER_DRAIN) { E(acc, cur, wr, wc, fr, fq); S.done(cur); }
        if (!has_next) break;
#pragma unroll
        for (int a = 0; a < 2; ++a)
#pragma unroll
            for (int b = 0; b < 2; ++b)
#pragma unroll
                for (int m = 0; m < 4; ++m)
#pragma unroll
                    for (int n = 0; n < 2; ++n) acc[a][b][m][n] = (f32x4){0.f, 0.f, 0.f, 0.f};
        cur = nxt; cA = nA; cB = nB; ++ui;
        if constexpr (ALIGN_EPI) { if (wr == 1) PG8_BAR; }
    }
    PG8_WAIT_V(0);
    if constexpr (!ALIGN_EPI) { if (wr == 0) PG8_BAR; }
    PG8_BAR;
#undef PG8_SA
#undef PG8_SB
#undef PG8_STAGE
#undef PG8_LDA
#undef PG8_LDB
#undef PG8_MMA
#undef PG8_WAIT_V
#undef PG8_WAIT_L
#undef PG8_BAR
#undef PG8_SCHED
}
}

#define XB_TMO      128
#define XB_XCNT(j)  (256  + 64 * (j))
#define XB_XSUB(j)  (1280 + 64 * (j))
#define XB_XGEN(j)  (2304 + 64 * (j))
#define XB_TOP      3328
#define XB_TOPGEN   3392
#define XCD_BAR_WORDS 3456
#define XB_SPIN_CAP (1u << 20)
__device__ __forceinline__ unsigned xb_ld(unsigned* p)              { return __hip_atomic_load(p, __ATOMIC_RELAXED, __HIP_MEMORY_SCOPE_AGENT); }
__device__ __forceinline__ unsigned xb_add(unsigned* p, unsigned v) { return __hip_atomic_fetch_add(p, v, __ATOMIC_RELAXED, __HIP_MEMORY_SCOPE_AGENT); }
__device__ __forceinline__ unsigned xb_xcc_id() { return (unsigned)__builtin_amdgcn_s_getreg((3 << 11) | 20) & 0xFu; }
#define XB_SPIN(cond, bar) do { unsigned _sp = 0; while (cond) { __builtin_amdgcn_s_sleep(1); \
    if ((++_sp & 255u) == 0u) { if (xb_ld(&(bar)[XB_TMO])) break; if (_sp > XB_SPIN_CAP) { atomicAdd(&(bar)[XB_TMO], 1u); break; } } } } while (0)
struct XcdBarrier { unsigned* bar; unsigned x; volatile LAS unsigned* st; unsigned G; };
__device__ __forceinline__ XcdBarrier xcd_barrier_post(unsigned* bar, volatile LAS unsigned* st, unsigned G, bool member) {
    XcdBarrier b; b.bar = bar; b.x = xb_xcc_id(); b.st = st; b.G = G;
    if (member && threadIdx.x == 0) (void)xb_add(&bar[XB_XCNT(b.x)], 1u);
    return b;
}
__device__ __forceinline__ void xcd_barrier_complete(unsigned* bar, unsigned x, unsigned& nloc, unsigned& nx, const unsigned G) {
    unsigned sum, cnt, mine, sp = 0u;
    for (;;) {
        sum = 0u; cnt = 0u; mine = 0u;
#pragma unroll
        for (unsigned j = 0; j < 16; ++j) { const unsigned c = xb_ld(&bar[XB_XCNT(j)]); sum += c; cnt += (c > 0u) ? 1u : 0u; mine = (j == x) ? c : mine; }
        if (sum == G) break;
        __builtin_amdgcn_s_sleep(1);
        if ((++sp & 255u) == 0u) { if (xb_ld(&bar[XB_TMO])) break; if (sp > XB_SPIN_CAP) { atomicAdd(&bar[XB_TMO], 1u); break; } }
    }
    nloc = mine > 0u ? mine : 1u; nx = cnt > 0u ? cnt : 1u;
}
__device__ __forceinline__ void xcd_barrier(const XcdBarrier& b) {
    asm volatile("s_waitcnt vmcnt(0)" ::: "memory");
    __syncthreads();
    if (threadIdx.x == 0) {
        unsigned* bar = b.bar;
        __builtin_amdgcn_s_waitcnt(0);
        unsigned nloc = b.st[0], nx = b.st[1];
        if (nloc == 0u) { xcd_barrier_complete(bar, b.x, nloc, nx, b.G); b.st[0] = nloc; b.st[1] = nx; }
        const unsigned old = xb_add(&bar[XB_XSUB(b.x)], 1u);
        const unsigned gen = old / nloc;
        if (old + 1u == (gen + 1u) * nloc) {
            __builtin_amdgcn_fence(__ATOMIC_RELEASE, "agent");
            asm volatile("s_waitcnt vmcnt(0)" ::: "memory");
            const unsigned og = xb_add(&bar[XB_TOP], 1u);
            const unsigned tg = og / nx;
            if (og + 1u == (tg + 1u) * nx) xb_add(&bar[XB_TOPGEN], 1u);
            else XB_SPIN(xb_ld(&bar[XB_TOPGEN]) == tg, bar);
            __builtin_amdgcn_fence(__ATOMIC_ACQUIRE, "agent");
            xb_add(&bar[XB_XGEN(b.x)], 1u);
            asm volatile("s_waitcnt vmcnt(0)" ::: "memory");
        } else {
            XB_SPIN(xb_ld(&bar[XB_XGEN(b.x)]) == gen, bar);
            __builtin_amdgcn_fence(__ATOMIC_ACQUIRE, "agent");
            asm volatile("s_waitcnt vmcnt(0)" ::: "memory");
        }
    }
    __syncthreads();
}

__device__ __forceinline__ void transpose_item(const float* W, int K, int N, bf16* WT, LAS float* scr, int item, int nblk, int lane) {
    const int kb = item / nblk, nb = item % nblk, k0 = 64 * kb, n0 = 32 * nb;
    const int ncol = n0 + (lane & 31); const bool ok = ncol < N;
#pragma unroll 8
    for (int i = 0; i < 32; ++i) { const int kk = 2 * i + (lane >> 5); scr[kk * 33 + (lane & 31)] = ok ? W[(size_t)(k0 + kk) * N + ncol] : 0.f; }
    asm volatile("s_waitcnt lgkmcnt(0)" ::: "memory");
    const int c = lane & 7;
#pragma unroll
    for (int j = 0; j < 4; ++j) { const int n = (lane >> 3) + 8 * j; const LAS float* s = scr + (8 * c) * 33 + n;
        u32x4 o; o.x = pk2(s[0 * 33], s[1 * 33]); o.y = pk2(s[2 * 33], s[3 * 33]); o.z = pk2(s[4 * 33], s[5 * 33]); o.w = pk2(s[6 * 33], s[7 * 33]);
        *(u32x4*)(WT + (size_t)(n0 + n) * K + k0 + 8 * c) = o; }
    asm volatile("s_waitcnt lgkmcnt(0)" ::: "memory");
}
constexpr int WI_IN = 16 * 120, WI_OUT = 16 * 32, WI_1 = 16 * 128, WI_2 = 64 * 32, WI_ALL = WI_IN + WI_OUT + WI_1 + WI_2;
__device__ __forceinline__ void phase_weights(LAS unsigned char* lds, const float* w_in, const float* w_out, const float* w1, const float* w2, unsigned char* wsW, int it_lo, int it_hi, int it_step, int wave, int lane) {
    LAS float* scr = (LAS float*)(lds + wave * 16384);
    constexpr int I_IN = WI_IN, I_OUT = WI_OUT, I_1 = WI_1;
    for (int it = it_lo; it < it_hi; it += it_step) {
        int r = it;
        if (r < I_IN) { transpose_item(w_in, D, INC, (bf16*)(wsW + WOFF_IN), scr, r, 120, lane); continue; } r -= I_IN;
        if (r < I_OUT) { transpose_item(w_out, D, D, (bf16*)(wsW + WOFF_OUT), scr, r, 32, lane); continue; } r -= I_OUT;
        if (r < I_1) { transpose_item(w1, D, FF, (bf16*)(wsW + WOFF_W1), scr, r, 128, lane); continue; } r -= I_1;
        transpose_item(w2, FF, D, (bf16*)(wsW + WOFF_W2), scr, r, 32, lane);
    }
}
__device__ __forceinline__ void phase_mod(LAS unsigned char* lds, const float* c, const float* c_ctx, const float* w_mod, const float* b_mod, float* MOD, int tid, int bid, int G) {
    LAS float* sc = (LAS float*)lds;
    LAS float* red = sc + NMODC * 1024;
    const int wave = tid >> 6, lane = tid & 63;
    if (bid >= 192) return;
    for (int i = tid; i < NMODC * 1024; i += NTHR) { const int ci = i >> 10, k = i & 1023; const float x = ci == 0 ? c_ctx[k] : c[(ci - 1) * 1024 + k]; sc[i] = siluf_(x); }
    __syncthreads();
    for (int task = bid; task < 192; task += G) {
        const int l = task / 96, cg = task % 96, col = cg * 64 + lane;
        float acc[NMODC];
#pragma unroll
        for (int ci = 0; ci < NMODC; ++ci) acc[ci] = 0.f;
        const float* wp = w_mod + ((size_t)l * 1024 + wave * 128) * 6144 + col;
#pragma unroll 4
        for (int k = 0; k < 128; ++k) { const float wv = wp[(size_t)k * 6144];
#pragma unroll
            for (int ci = 0; ci < NMODC; ++ci) acc[ci] += sc[ci * 1024 + wave * 128 + k] * wv; }
#pragma unroll
        for (int ci = 0; ci < NMODC; ++ci) red[(wave * NMODC + ci) * 64 + lane] = acc[ci];
        __syncthreads();
        for (int i = tid; i < NMODC * 64; i += NTHR) { const int ci = i >> 6, ln = i & 63; float s = b_mod[l * 6144 + cg * 64 + ln];
#pragma unroll
            for (int w = 0; w < 8; ++w) s += red[(w * NMODC + ci) * 64 + ln];
            MOD[((size_t)l * NMODC + ci) * 6144 + cg * 64 + ln] = s; }
        __syncthreads();
    }
}
__device__ __forceinline__ void phase_norm(const float* xc, const float* xl, const float* ng, const float* MODl, int sh_off, int sc_off, bf16* XN, int m_lo, int m_hi, int gw, int NGW, int lane) {
    for (int m = m_lo + gw; m < m_hi; m += NGW) {
        const float* xrow = m < MCTX ? xc + (size_t)m * D : xl + (size_t)(m - MCTX) * D;
        const int ci = m < MCTX ? 0 : 1 + ((m - MCTX) >> 11);
        const f32x4* xr = (const f32x4*)xrow + lane;
        f32x4 v[4]; float s = 0.f;
#pragma unroll
        for (int j = 0; j < 4; ++j) { v[j] = xr[64 * j]; s += (v[j].x * v[j].x + v[j].y * v[j].y) + (v[j].z * v[j].z + v[j].w * v[j].w); }
        const float rstd = rsqrtf(wave_sum(s, lane) * (1.f / D) + 1e-6f);
        u32x2* o8 = (u32x2*)(XN + (size_t)m * D) + lane;
#pragma unroll
        for (int j = 0; j < 4; ++j) { const int k = 4 * lane + 256 * j;
            const f32x4 g4 = *(const f32x4*)(ng + k), sc4 = *(const f32x4*)(MODl + ci * 6144 + sc_off + k), sh4 = *(const f32x4*)(MODl + ci * 6144 + sh_off + k);
            const f32x4 o = v[j] * rstd * g4 * (sc4 + 1.0f) + sh4;
            u32x2 w; w.x = pk2(o.x, o.y); w.y = pk2(o.z, o.w); o8[64 * j] = w; }
    }
}
__device__ __forceinline__ void phase_final_norm(float* x, const float* fg, int m_lo, int m_hi, int gw, int NGW, int lane) {
    for (int m = m_lo + gw; m < m_hi; m += NGW) {
        f32x4* xr = (f32x4*)(x + (size_t)m * D) + lane;
        f32x4 v[4]; float s = 0.f;
#pragma unroll
        for (int j = 0; j < 4; ++j) { v[j] = xr[64 * j]; s += (v[j].x * v[j].x + v[j].y * v[j].y) + (v[j].z * v[j].z + v[j].w * v[j].w); }
        const float rstd = rsqrtf(wave_sum(s, lane) * (1.f / D) + 1e-6f);
#pragma unroll
        for (int j = 0; j < 4; ++j) { const f32x4 g4 = *(const f32x4*)(fg + 4 * lane + 256 * j); xr[64 * j] = v[j] * rstd * g4; }
    }
}

__device__ __forceinline__ void shiftmix8(const bf16* zr, int col, bool hasp, bool hasn, const float* mu, float (&o)[8]) {
    float c[8], p[8], n[8], mv[8];
    ld8(zr + col, c);
    if (hasp) ld8(zr - ZP + col, p); else {
#pragma unroll
        for (int j = 0; j < 8; ++j) p[j] = 0.f; }
    if (hasn) ld8(zr + ZP + col, n); else {
#pragma unroll
        for (int j = 0; j < 8; ++j) n[j] = 0.f; }
    ldf8(mu + (col - OFF_C), mv);
#pragma unroll
    for (int j = 0; j < 8; ++j) o[j] = c[j] + mv[j] * (0.5f * (p[j] + n[j]) - c[j]);
}

__device__ __forceinline__ void unit_gmlp(LAS unsigned char* lds, bf16* Z, const float* ln_g, const float* w_s, const float* b_s, int cidx, int g, int tid) {
    LAS float* vn = (LAS float*)lds;
    const int s = tid >> 2, qd = tid & 3;
    bf16* zrow = Z + (size_t)(cidx * 128 + s) * ZP;
    {
        float x[16];
        { float a[8], b[8]; ld8(zrow + 256 + 64 * g + qd * 16, a); ld8(zrow + 256 + 64 * g + qd * 16 + 8, b);
#pragma unroll
          for (int j = 0; j < 8; ++j) { x[j] = geluf_(a[j]); x[8 + j] = geluf_(b[j]); } }
        float sum = 0.f;
#pragma unroll
        for (int j = 0; j < 16; ++j) sum += x[j];
        sum = sum4(sum);
        const float mean = sum * (1.f / 64.f);
        float sq = 0.f;
#pragma unroll
        for (int j = 0; j < 16; ++j) { x[j] -= mean; sq += x[j] * x[j]; }
        sq = sum4(sq);
        const float rstd = rsqrtf(sq * (1.f / 64.f) + 1e-5f);
        float lga[8], lgb[8]; ldf8(ln_g + 64 * g + qd * 16, lga); ldf8(ln_g + 64 * g + qd * 16 + 8, lgb);
#pragma unroll
        for (int j4 = 0; j4 < 2; ++j4) {
            *(LAS f32x4*)(vn + s * 68 + qd * 16 + 4 * j4) = (f32x4){x[4 * j4] * rstd * lga[4 * j4], x[4 * j4 + 1] * rstd * lga[4 * j4 + 1], x[4 * j4 + 2] * rstd * lga[4 * j4 + 2], x[4 * j4 + 3] * rstd * lga[4 * j4 + 3]};
            *(LAS f32x4*)(vn + s * 68 + qd * 16 + 8 + 4 * j4) = (f32x4){x[8 + 4 * j4] * rstd * lgb[4 * j4], x[8 + 4 * j4 + 1] * rstd * lgb[4 * j4 + 1], x[8 + 4 * j4 + 2] * rstd * lgb[4 * j4 + 2], x[8 + 4 * j4 + 3] * rstd * lgb[4 * j4 + 3]}; }
    }
    __syncthreads();
    float acc[16];
#pragma unroll
    for (int j = 0; j < 16; ++j) acc[j] = 0.f;
    const float* wrow = w_s + ((size_t)g * 128 + s) * 128;
#pragma unroll 2
    for (int s4 = 0; s4 < 128; s4 += 4) {
        const f32x4 w4 = *(const f32x4*)(wrow + s4);
#pragma unroll
        for (int i = 0; i < 4; ++i) { const LAS f32x4* vr = (const LAS f32x4*)(vn + (s4 + i) * 68 + qd * 16);
#pragma unroll
            for (int j4 = 0; j4 < 4; ++j4) { const f32x4 a = vr[j4]; acc[4 * j4] += w4[i] * a.x; acc[4 * j4 + 1] += w4[i] * a.y; acc[4 * j4 + 2] += w4[i] * a.z; acc[4 * j4 + 3] += w4[i] * a.w; } }
    }
    const float bias = b_s[g * 128 + s];
    {
        float a[8], b[8]; ld8(zrow + 64 * g + qd * 16, a); ld8(zrow + 64 * g + qd * 16 + 8, b);
#pragma unroll
        for (int j = 0; j < 8; ++j) { a[j] = geluf_(a[j]) * (acc[j] + bias); b[j] = geluf_(b[j]) * (acc[8 + j] + bias); }
        st8(zrow + 64 * g + qd * 16, a); st8(zrow + 64 * g + qd * 16 + 8, b);
    }
    __syncthreads();
}

#define LDS_BARRIER() do { asm volatile("s_waitcnt lgkmcnt(0)" ::: "memory"); __builtin_amdgcn_s_barrier(); asm volatile("" ::: "memory"); } while (0)
#define DPPF(old, x, ctrl, rmask, bc) __uint_as_float(__builtin_amdgcn_update_dpp(__float_as_uint(old), __float_as_uint(x), ctrl, rmask, 0xf, bc))
__device__ __forceinline__ float wave_scan_add(float x) {
    x += DPPF(0.f, x, 0x111, 0xf, true); x += DPPF(0.f, x, 0x112, 0xf, true); x += DPPF(0.f, x, 0x114, 0xf, true); x += DPPF(0.f, x, 0x118, 0xf, true);
    x += DPPF(0.f, x, 0x142, 0xa, true); x += DPPF(0.f, x, 0x143, 0xc, true);
    return x;
}
__device__ __forceinline__ float wave_scan_max(float x) {
    const float ninf = -__builtin_inff();
    x = fmaxf(x, DPPF(ninf, x, 0x111, 0xf, false)); x = fmaxf(x, DPPF(ninf, x, 0x112, 0xf, false)); x = fmaxf(x, DPPF(ninf, x, 0x114, 0xf, false)); x = fmaxf(x, DPPF(ninf, x, 0x118, 0xf, false));
    x = fmaxf(x, DPPF(ninf, x, 0x142, 0xa, false)); x = fmaxf(x, DPPF(ninf, x, 0x143, 0xc, false));
    return x;
}
__device__ __forceinline__ u32x2 pack4bf(const f32x4 v) { u32x2 w; w.x = pk2(v[0], v[1]); w.y = pk2(v[2], v[3]); return w; }
#define MFMA16(a, b, c) __builtin_amdgcn_mfma_f32_16x16x32_bf16(a, b, c, 0, 0, 0)

__device__ __forceinline__ void unit_mlstm(LAS unsigned char* lds, const bf16* Z, bf16* HS, const float* conv, const float* gate_b,
                                           const float* C0, const float* n0, const float* m0, float* Cout, float* nout, float* mout,
                                           int rowbase, int T, int r, int h, int tid) {
    constexpr int P = 72;
    LAS bf16* Qb = (LAS bf16*)lds;
    LAS bf16* Kb = Qb + 64 * P;
    LAS bf16* KwT = Kb + 64 * P;
    LAS bf16* VT = KwT + 64 * P;
    LAS bf16* Sb = VT + 80 * P;
    LAS bf16* CTb = Sb + 64 * P;
    LAS float* e1 = (LAS float*)(CTb + 80 * P);
    LAS float* e2 = e1 + 64;
    LAS float* gin = e2 + 64;
    LAS float* emt = gin + 64;
    const int wave = __builtin_amdgcn_readfirstlane(tid >> 6), lane = tid & 63, fr = lane & 15, fq = lane >> 4;
    const int tau = tid >> 3, oct = tid & 7;
    const int mtC = wave & 3, ntC0 = 2 * (wave >> 2);
    for (int i = tid; i < 16 * P; i += NTHR) { VT[64 * P + i] = (i < P) ? (bf16)0x3F80 : (bf16)0; CTb[64 * P + i] = 0; }
    f32x4 Cacc[3];
#pragma unroll
    for (int t = 0; t < 3; ++t) {
        const int nt = t < 2 ? ntC0 + t : 4, dv = 16 * nt + fr;
#pragma unroll
        for (int i = 0; i < 4; ++i) { const int dk = 16 * mtC + 4 * fq + i; float v = 0.f;
            if (C0) { if (t < 2) v = C0[dk * 64 + dv]; else if (fr == 0) v = n0[dk]; }
            Cacc[t][i] = v; }
    }
    float ms = C0 ? m0[0] : 0.f;
    float cq[3][8], ck[3][8];
#pragma unroll
    for (int i = 0; i < 3; ++i) { ldf8(conv + i * 768 + 64 * h + 8 * oct, cq[i]); ldf8(conv + i * 768 + 384 + 64 * h + 8 * oct, ck[i]); }
    const float gbi = gate_b[r * 12 + h], gbf = gate_b[r * 12 + 6 + h];
    LDS_BARRIER();
#pragma unroll
    for (int t = 0; t < 3; ++t) { const int nt = t < 2 ? ntC0 + t : 4; if (t < 2 || wave < 4) *(LAS u32x2*)(CTb + (16 * nt + fr) * P + 16 * mtC + 4 * fq) = pack4bf(Cacc[t]); }
    const int nch = T / 64;
    const int qcol = OFF_QK + 64 * h + 8 * oct, kcol = OFF_QK + 384 + 64 * h + 8 * oct, vcol = OFF_V + 64 * h + 8 * oct;
    u32x4 rq[3], rk[3], rv; unsigned short rgi, rgf;
    const u32x4 zero4 = (u32x4){0u, 0u, 0u, 0u};
#define ML_LOAD(c) do { const int tq_ = r ? T - 1 - (64 * (c) + tau) : 64 * (c) + tau; const bf16* zr_ = Z + ((size_t)rowbase + tq_) * ZP; \
        rq[1] = *(const u32x4*)(zr_ + qcol); rk[1] = *(const u32x4*)(zr_ + kcol); rv = *(const u32x4*)(zr_ + vcol); \
        rq[0] = tq_ > 0 ? *(const u32x4*)(zr_ - ZP + qcol) : zero4; rk[0] = tq_ > 0 ? *(const u32x4*)(zr_ - ZP + kcol) : zero4; \
        rq[2] = tq_ < T - 1 ? *(const u32x4*)(zr_ + ZP + qcol) : zero4; rk[2] = tq_ < T - 1 ? *(const u32x4*)(zr_ + ZP + kcol) : zero4; \
        const int tl_ = r ? T - 1 - (64 * (c) + lane) : 64 * (c) + lane; const bf16* zg_ = Z + ((size_t)rowbase + tl_) * ZP + OFF_G + 12 * r; rgi = zg_[h]; rgf = zg_[6 + h]; } while (0)
    ML_LOAD(0);
#pragma unroll 1
    for (int ci = 0; ci < nch; ++ci) {
        const float gil = bf2f(rgi) + gbi;
        const float bcs = wave_scan_add(logsigf_(bf2f(rgf) + gbf));
        const float pmx = wave_scan_max(gil - bcs);
        const float mt = bcs + fmaxf(ms, pmx);
        const float b63 = __uint_as_float(__builtin_amdgcn_readlane(__float_as_uint(bcs), 63)), mnew = __uint_as_float(__builtin_amdgcn_readlane(__float_as_uint(mt), 63));
        const float ginl = __expf(bcs + ms - mt);
        const float wendl = __expf(b63 - bcs + gil - mnew);
        const float cd = __expf(b63 + ms - mnew);
        ms = mnew;
        if (wave == 0) { e1[lane] = bcs - mt; e2[lane] = gil - bcs; gin[lane] = ginl; emt[lane] = __expf(-mt); }
        const float wend_t = bperm(wendl, 8 * (wave & 7) + (lane >> 3));
        {
            float c[8], p[8], n[8];
            { const u32x4 w = rq[1]; c[0] = __uint_as_float(w.x << 16); c[1] = __uint_as_float(w.x & 0xffff0000u); c[2] = __uint_as_float(w.y << 16); c[3] = __uint_as_float(w.y & 0xffff0000u); c[4] = __uint_as_float(w.z << 16); c[5] = __uint_as_float(w.z & 0xffff0000u); c[6] = __uint_as_float(w.w << 16); c[7] = __uint_as_float(w.w & 0xffff0000u); }
            { const u32x4 w = rq[0]; p[0] = __uint_as_float(w.x << 16); p[1] = __uint_as_float(w.x & 0xffff0000u); p[2] = __uint_as_float(w.y << 16); p[3] = __uint_as_float(w.y & 0xffff0000u); p[4] = __uint_as_float(w.z << 16); p[5] = __uint_as_float(w.z & 0xffff0000u); p[6] = __uint_as_float(w.w << 16); p[7] = __uint_as_float(w.w & 0xffff0000u); }
            { const u32x4 w = rq[2]; n[0] = __uint_as_float(w.x << 16); n[1] = __uint_as_float(w.x & 0xffff0000u); n[2] = __uint_as_float(w.y << 16); n[3] = __uint_as_float(w.y & 0xffff0000u); n[4] = __uint_as_float(w.z << 16); n[5] = __uint_as_float(w.z & 0xffff0000u); n[6] = __uint_as_float(w.w << 16); n[7] = __uint_as_float(w.w & 0xffff0000u); }
#pragma unroll
            for (int j = 0; j < 8; ++j) c[j] = siluf_(p[j] * cq[0][j] + c[j] * cq[1][j] + n[j] * cq[2][j]);
            { u32x4 w; w.x = pk2(c[0], c[1]); w.y = pk2(c[2], c[3]); w.z = pk2(c[4], c[5]); w.w = pk2(c[6], c[7]); *(LAS u32x4*)(Qb + tau * P + 8 * oct) = w; }
            { const u32x4 w = rk[1]; c[0] = __uint_as_float(w.x << 16); c[1] = __uint_as_float(w.x & 0xffff0000u); c[2] = __uint_as_float(w.y << 16); c[3] = __uint_as_float(w.y & 0xffff0000u); c[4] = __uint_as_float(w.z << 16); c[5] = __uint_as_float(w.z & 0xffff0000u); c[6] = __uint_as_float(w.w << 16); c[7] = __uint_as_float(w.w & 0xffff0000u); }
            { const u32x4 w = rk[0]; p[0] = __uint_as_float(w.x << 16); p[1] = __uint_as_float(w.x & 0xffff0000u); p[2] = __uint_as_float(w.y << 16); p[3] = __uint_as_float(w.y & 0xffff0000u); p[4] = __uint_as_float(w.z << 16); p[5] = __uint_as_float(w.z & 0xffff0000u); p[6] = __uint_as_float(w.w << 16); p[7] = __uint_as_float(w.w & 0xffff0000u); }
            { const u32x4 w = rk[2]; n[0] = __uint_as_float(w.x << 16); n[1] = __uint_as_float(w.x & 0xffff0000u); n[2] = __uint_as_float(w.y << 16); n[3] = __uint_as_float(w.y & 0xffff0000u); n[4] = __uint_as_float(w.z << 16); n[5] = __uint_as_float(w.z & 0xffff0000u); n[6] = __uint_as_float(w.w << 16); n[7] = __uint_as_float(w.w & 0xffff0000u); }
#pragma unroll
            for (int j = 0; j < 8; ++j) c[j] = 0.125f * siluf_(p[j] * ck[0][j] + c[j] * ck[1][j] + n[j] * ck[2][j]);
            { u32x4 w; w.x = pk2(c[0], c[1]); w.y = pk2(c[2], c[3]); w.z = pk2(c[4], c[5]); w.w = pk2(c[6], c[7]); *(LAS u32x4*)(Kb + tau * P + 8 * oct) = w; }
#pragma unroll
            for (int j = 0; j < 8; ++j) KwT[(8 * oct + j) * P + tau] = (bf16)f2bf(c[j] * wend_t);
            const unsigned vw[4] = {rv.x, rv.y, rv.z, rv.w};
#pragma unroll
            for (int j = 0; j < 4; ++j) { VT[(8 * oct + 2 * j) * P + tau] = (bf16)(vw[j] & 0xffffu); VT[(8 * oct + 2 * j + 1) * P + tau] = (bf16)(vw[j] >> 16); }
        }
        if (ci + 1 < nch) ML_LOAD(ci + 1);
        LDS_BARRIER();
        const int ntT = wave & 3, mt0 = 2 * (wave >> 2);
        f32x4 qc[3];
        {
            bf16x8 bq[2];
#pragma unroll
            for (int ks = 0; ks < 2; ++ks) bq[ks] = *(const LAS bf16x8*)(Qb + (16 * ntT + fr) * P + 32 * ks + 8 * fq);
            const float e1t = e1[16 * ntT + fr];
#pragma unroll
            for (int t = 0; t < 2; ++t) {
                const int mt_ = mt0 + t;
                f32x4 a = (f32x4){0.f, 0.f, 0.f, 0.f};
#pragma unroll
                for (int ks = 0; ks < 2; ++ks) a = MFMA16(*(const LAS bf16x8*)(Kb + (16 * mt_ + fr) * P + 32 * ks + 8 * fq), bq[ks], a);
                const f32x4 e2v = *(const LAS f32x4*)(e2 + 16 * mt_ + 4 * fq);
#pragma unroll
                for (int i = 0; i < 4; ++i) { const int sg = 16 * mt_ + 4 * fq + i; a[i] = sg <= 16 * ntT + fr ? a[i] * __expf(e1t + e2v[i]) : 0.f; }
                *(LAS u32x2*)(Sb + (16 * ntT + fr) * P + 16 * mt_ + 4 * fq) = pack4bf(a);
            }
#pragma unroll
            for (int t = 0; t < 3; ++t) {
                const int mt_ = t < 2 ? mt0 + t : 4;
                f32x4 a = (f32x4){0.f, 0.f, 0.f, 0.f};
#pragma unroll
                for (int ks = 0; ks < 2; ++ks) a = MFMA16(*(const LAS bf16x8*)(CTb + (16 * mt_ + fr) * P + 32 * ks + 8 * fq), bq[ks], a);
                qc[t] = a;
            }
        }
        LDS_BARRIER();
        {
            bf16x8 bs[2];
#pragma unroll
            for (int ks = 0; ks < 2; ++ks) bs[ks] = *(const LAS bf16x8*)(Sb + (16 * ntT + fr) * P + 32 * ks + 8 * fq);
            f32x4 sv[3];
#pragma unroll
            for (int t = 0; t < 3; ++t) {
                const int mt_ = t < 2 ? mt0 + t : 4;
                f32x4 a = (f32x4){0.f, 0.f, 0.f, 0.f};
#pragma unroll
                for (int ks = 0; ks < 2; ++ks) a = MFMA16(*(const LAS bf16x8*)(VT + (16 * mt_ + fr) * P + 32 * ks + 8 * fq), bs[ks], a);
                sv[t] = a;
            }
            const int tt = 16 * ntT + fr;
            const float gt = gin[tt];
            const float den = bperm(sv[2][0], fr) + gt * bperm(qc[2][0], fr);
            const float inv = 1.0f / fmaxf(fabsf(den), emt[tt]);
            const int tq = r ? T - 1 - (64 * ci + tt) : 64 * ci + tt;
            bf16* hrow = HS + ((size_t)r * M + rowbase + tq) * 384 + 64 * h;
#pragma unroll
            for (int t = 0; t < 2; ++t) { const f32x4 o = (sv[t] + gt * qc[t]) * inv; *(u32x2*)(hrow + 16 * (mt0 + t) + 4 * fq) = pack4bf(o); }
            bf16x8 ak[2];
#pragma unroll
            for (int ks = 0; ks < 2; ++ks) ak[ks] = *(const LAS bf16x8*)(KwT + (16 * mtC + fr) * P + 32 * ks + 8 * fq);
#pragma unroll
            for (int t = 0; t < 3; ++t) {
                const int nt = t < 2 ? ntC0 + t : 4;
                f32x4 a = Cacc[t] * cd;
#pragma unroll
                for (int ks = 0; ks < 2; ++ks) a = MFMA16(ak[ks], *(const LAS bf16x8*)(VT + (16 * nt + fr) * P + 32 * ks + 8 * fq), a);
                Cacc[t] = a;
            }
        }
        LDS_BARRIER();
#pragma unroll
        for (int t = 0; t < 3; ++t) { const int nt = t < 2 ? ntC0 + t : 4; if (t < 2 || wave < 4) *(LAS u32x2*)(CTb + (16 * nt + fr) * P + 16 * mtC + 4 * fq) = pack4bf(Cacc[t]); }
    }
#undef ML_LOAD
    if (Cout) {
#pragma unroll
        for (int t = 0; t < 2; ++t)
#pragma unroll
            for (int i = 0; i < 4; ++i) Cout[(16 * mtC + 4 * fq + i) * 64 + 16 * (ntC0 + t) + fr] = Cacc[t][i];
        if (wave < 4 && fr == 0) {
#pragma unroll
            for (int i = 0; i < 4; ++i) nout[16 * mtC + 4 * fq + i] = Cacc[2][i]; }
        if (tid == 0) mout[0] = ms;
    }
    LDS_BARRIER();
}

__device__ __forceinline__ void unit_rwkv(LAS unsigned char* lds, const bf16* Z, bf16* YS, float* BON, const float* mu, const float* w0, const float* w2, const float* a0, const float* a2,
                                          const float* k_k, const float* k_a, const float* r_k, const float* S0, float* Sout_base, int sout_idx, int rowbase, int T, int r, int h, int tid) {
    constexpr int P = 72, IMG = 64 * P, PL = 68, PD = 24;
    LAS bf16* img = (LAS bf16*)lds;
    LAS bf16 *W2T = img, *A2T = img + IMG, *At = img + 2 * IMG, *Rt = img + 3 * IMG, *Btk = img + 4 * IMG, *Ktk = img + 5 * IMG, *Bkj = img + 6 * IMG, *Kkj = img + 7 * IMG,
             *Vvj = img + 8 * IMG, *Svk = img + 9 * IMG, *MkT = img + 10 * IMG, *NbT = img + 11 * IMG, *NkT = img + 12 * IMG, *TT = img + 13 * IMG, *Mbj = img + 14 * IMG;
    LAS bf16 *Xvt = Btk, *Uvj = Ktk, *DWb = MkT, *DAb = NbT;
    LAS float* LD = (LAS float*)(img + 12 * IMG);
    LAS float* LW = LD + 64 * PL;
    LAS bf16* AA = (LAS bf16*)(LW + 64 * PL);
    LAS float* MD = (LAS float*)(img + 15 * IMG);
    LAS bf16* TD = (LAS bf16*)(MD + 1024);
    LAS bf16* PTs = TD + 64 * PD;
    LAS float* DL = (LAS float*)((LAS unsigned char*)lds + 154624);
    LAS float* CST = DL + 64;
    const int wave = __builtin_amdgcn_readfirstlane(tid >> 6), lane = tid & 63, fr = lane & 15, fq = lane >> 4;
    const int tau = tid >> 3, oct = tid & 7;
    const int ntW = wave & 3, mt0 = 2 * (wave >> 2);
    const bf16x8 zf = (bf16x8){0, 0, 0, 0, 0, 0, 0, 0};
#define FR(im, row, ks) (*(const LAS bf16x8*)((im) + (row) * P + 32 * (ks) + 8 * fq))
    for (int i = tid; i < 640; i += NTHR) { const int g = i >> 6, c = i & 63; float v;
        if (g == 0) v = mu[64 * h + c]; else if (g == 1) v = mu[384 + 64 * h + c]; else if (g == 2) v = mu[768 + 64 * h + c]; else if (g == 3) v = mu[1152 + 64 * r + c]; else if (g == 4) v = mu[1280 + 64 * r + c];
        else if (g == 5) v = k_k[64 * h + c]; else if (g == 6) v = k_a[64 * h + c]; else if (g == 7) v = r_k[64 * h + c]; else if (g == 8) v = w0[r * 384 + 64 * h + c]; else v = a0[r * 384 + 64 * h + c];
        CST[i] = v; }
    {
        float a[8], b[8];
#pragma unroll
        for (int j = 0; j < 8; ++j) { a[j] = w2[((size_t)r * 64 + 8 * oct + j) * 384 + 64 * h + tau]; b[j] = a2[((size_t)r * 64 + 8 * oct + j) * 384 + 64 * h + tau]; }
        u32x4 w; w.x = pk2(a[0], a[1]); w.y = pk2(a[2], a[3]); w.z = pk2(a[4], a[5]); w.w = pk2(a[6], a[7]); *(LAS u32x4*)(W2T + tau * P + 8 * oct) = w;
        w.x = pk2(b[0], b[1]); w.y = pk2(b[2], b[3]); w.z = pk2(b[4], b[5]); w.w = pk2(b[6], b[7]); *(LAS u32x4*)(A2T + tau * P + 8 * oct) = w;
    }
    f32x4 Sacc[2];
#pragma unroll
    for (int t = 0; t < 2; ++t) { Sacc[t] = S0 ? *(const f32x4*)(S0 + (16 * ntW + fr) * 64 + 16 * (mt0 + t) + 4 * fq) : (f32x4){0.f, 0.f, 0.f, 0.f};
        *(LAS u32x2*)(Svk + (16 * ntW + fr) * P + 16 * (mt0 + t) + 4 * fq) = pack4bf(Sacc[t]); }
    const int nch = T / 64;
    const int c_r = OFF_C + 64 * h + 8 * oct, c_k = OFF_C + 384 + 64 * h + 8 * oct, c_v = OFF_C + 768 + 64 * h + 8 * oct, c_w = OFF_C + 1152 + 64 * r + 8 * oct, c_a = OFF_C + 1280 + 64 * r + 8 * oct;
    u32x4 raw[5][3];
#define RW_LOAD(c) do { unsigned zq_; asm volatile("v_mov_b32 %0, 0" : "=v"(zq_)); const u32x4 zero4 = (u32x4){zq_, zq_, zq_, zq_}; const int tau = tid >> 3; const int tq_ = r ? T - 1 - (64 * (c) + tau) : 64 * (c) + tau; const bf16* zr_ = Z + ((size_t)rowbase + tq_) * ZP; const bool hp_ = tq_ > 0, hn_ = tq_ < T - 1; \
        const int cols_[5] = {c_r, c_k, c_v, c_w, c_a}; \
        _Pragma("unroll") for (int g_ = 0; g_ < 5; ++g_) { raw[g_][1] = *(const u32x4*)(zr_ + cols_[g_]); raw[g_][0] = hp_ ? *(const u32x4*)(zr_ - ZP + cols_[g_]) : zero4; raw[g_][2] = hn_ ? *(const u32x4*)(zr_ + ZP + cols_[g_]) : zero4; } } while (0)
#define UNPK(q_, o) do { const u32x4 q4_ = (q_); o[0] = __uint_as_float(q4_.x << 16); o[1] = __uint_as_float(q4_.x & 0xffff0000u); o[2] = __uint_as_float(q4_.y << 16); o[3] = __uint_as_float(q4_.y & 0xffff0000u); \
        o[4] = __uint_as_float(q4_.z << 16); o[5] = __uint_as_float(q4_.z & 0xffff0000u); o[6] = __uint_as_float(q4_.w << 16); o[7] = __uint_as_float(q4_.w & 0xffff0000u); } while (0)
#define MIX8(g, col, o) do { float c_[8], p_[8], n_[8], m_[8]; UNPK(raw[g][1], c_); UNPK(raw[g][0], p_); UNPK(raw[g][2], n_); { const f32x4 m0_ = *(const LAS f32x4*)(CST + 64 * (g) + 8 * oct), m1_ = *(const LAS f32x4*)(CST + 64 * (g) + 8 * oct + 4); m_[0] = m0_.x; m_[1] = m0_.y; m_[2] = m0_.z; m_[3] = m0_.w; m_[4] = m1_.x; m_[5] = m1_.y; m_[6] = m1_.z; m_[7] = m1_.w; } \
        _Pragma("unroll") for (int j_ = 0; j_ < 8; ++j_) o[j_] = c_[j_] + m_[j_] * (0.5f * (p_[j_] + n_[j_]) - c_[j_]); } while (0)
    RW_LOAD(0);
    LDS_BARRIER();
#pragma unroll 1
    for (int ci = 0; ci < nch; ++ci) {
        float rp[8], kp[8], kk[8];
        {
            int tl_ = tid; asm volatile("" : "+v"(tl_)); const int lane = tl_ & 63, fr = lane & 15, fq = lane >> 4, tau = tl_ >> 3, oct = tl_ & 7; (void)lane; (void)fr; (void)fq; (void)tau; (void)oct;
            float x[8];
            MIX8(0, c_r, rp); MIX8(1, c_k, kp);
            MIX8(2, c_v, x);
#pragma unroll
            for (int j = 0; j < 8; ++j) Vvj[(8 * oct + j) * P + tau] = (bf16)f2bf(x[j]);
            float kkv[8]; { const f32x4 m0_ = *(const LAS f32x4*)(CST + 320 + 8 * oct), m1_ = *(const LAS f32x4*)(CST + 320 + 8 * oct + 4); kkv[0] = m0_.x; kkv[1] = m0_.y; kkv[2] = m0_.z; kkv[3] = m0_.w; kkv[4] = m1_.x; kkv[5] = m1_.y; kkv[6] = m1_.z; kkv[7] = m1_.w; }
            float ss = 0.f;
#pragma unroll
            for (int j = 0; j < 8; ++j) { kkv[j] *= kp[j]; ss += kkv[j] * kkv[j]; }
            ss = sum8(ss);
            const float inv = 1.0f / fmaxf(sqrtf(ss), 1e-12f);
#pragma unroll
            for (int j = 0; j < 8; ++j) kk[j] = kkv[j] * inv;
            MIX8(3, c_w, x);
            { u32x4 w; w.x = pk2(tanhf_(x[0]), tanhf_(x[1])); w.y = pk2(tanhf_(x[2]), tanhf_(x[3])); w.z = pk2(tanhf_(x[4]), tanhf_(x[5])); w.w = pk2(tanhf_(x[6]), tanhf_(x[7])); *(LAS u32x4*)(DWb + tau * P + 8 * oct) = w; }
            MIX8(4, c_a, x);
            { u32x4 w; w.x = pk2(x[0], x[1]); w.y = pk2(x[2], x[3]); w.z = pk2(x[4], x[5]); w.w = pk2(x[6], x[7]); *(LAS u32x4*)(DAb + tau * P + 8 * oct) = w; }
        }
        LDS_BARRIER();
        {
            int tl_ = tid; asm volatile("" : "+v"(tl_)); const int lane = tl_ & 63, fr = lane & 15, fq = lane >> 4, tau = tl_ >> 3, oct = tl_ & 7; (void)lane; (void)fr; (void)fq; (void)tau; (void)oct;
            const int mt = wave & 3, th = wave >> 2;
            bf16x8 afw[2], afa[2];
#pragma unroll
            for (int ks = 0; ks < 2; ++ks) { afw[ks] = FR(W2T, 16 * mt + fr, ks); afa[ks] = FR(A2T, 16 * mt + fr, ks); }
            const f32x4 w0v = *(const LAS f32x4*)(CST + 512 + 16 * mt + 4 * fq), a0v = *(const LAS f32x4*)(CST + 576 + 16 * mt + 4 * fq);
            f32x4 carry = (f32x4){0.f, 0.f, 0.f, 0.f};
#pragma unroll
            for (int nt = 0; nt < 4; ++nt) {
                if (nt == 2 * th || nt == 2 * th + 1) {
                    f32x4 acc = (f32x4){0.f, 0.f, 0.f, 0.f};
#pragma unroll
                    for (int ks = 0; ks < 2; ++ks) acc = MFMA16(afw[ks], FR(DWb, 16 * nt + fr, ks), acc);
                    f32x4 lw, sc;
#pragma unroll
                    for (int i = 0; i < 4; ++i) { lw[i] = -__expf(logsigf_(acc[i] + w0v[i]) - 0.5f); float x = lw[i];
                        x += DPPF(0.f, x, 0x111, 0xf, true); x += DPPF(0.f, x, 0x112, 0xf, true); x += DPPF(0.f, x, 0x114, 0xf, true); x += DPPF(0.f, x, 0x118, 0xf, true);
                        sc[i] = x; }
                    {
                        const f32x4 ld = carry + sc;
                        *(LAS f32x4*)(LD + (16 * nt + fr) * PL + 16 * mt + 4 * fq) = ld; *(LAS f32x4*)(LW + (16 * nt + fr) * PL + 16 * mt + 4 * fq) = lw;
                        f32x4 ua = (f32x4){0.f, 0.f, 0.f, 0.f};
#pragma unroll
                        for (int ks = 0; ks < 2; ++ks) ua = MFMA16(afa[ks], FR(DAb, 16 * nt + fr, ks), ua);
#pragma unroll
                        for (int i = 0; i < 4; ++i) ua[i] = sigmoidf_(ua[i] + a0v[i]);
                        *(LAS u32x2*)(AA + (16 * nt + fr) * P + 16 * mt + 4 * fq) = pack4bf(ua);
                    }
#pragma unroll
                    for (int i = 0; i < 4; ++i) carry[i] += bperm(sc[i], (lane & 48) | 15);
                }
            }
        }
        LDS_BARRIER();
        {
            int tl_ = tid; asm volatile("" : "+v"(tl_)); const int lane = tl_ & 63, fr = lane & 15, fq = lane >> 4, tau = tl_ >> 3, oct = tl_ & 7; (void)lane; (void)fr; (void)fq; (void)tau; (void)oct;
            float ld[8], lw[8], a[8];
            { const f32x4 x0 = *(const LAS f32x4*)(LD + tau * PL + 8 * oct), x1 = *(const LAS f32x4*)(LD + tau * PL + 8 * oct + 4); ld[0] = x0.x; ld[1] = x0.y; ld[2] = x0.z; ld[3] = x0.w; ld[4] = x1.x; ld[5] = x1.y; ld[6] = x1.z; ld[7] = x1.w; }
            { const f32x4 x0 = *(const LAS f32x4*)(LW + tau * PL + 8 * oct), x1 = *(const LAS f32x4*)(LW + tau * PL + 8 * oct + 4); lw[0] = x0.x; lw[1] = x0.y; lw[2] = x0.z; lw[3] = x0.w; lw[4] = x1.x; lw[5] = x1.y; lw[6] = x1.z; lw[7] = x1.w; }
            { const u32x4 w = *(const LAS u32x4*)(AA + tau * P + 8 * oct); UNPK(w, a); }
            if (tau >= 32) { const f32x4 x0 = *(const LAS f32x4*)(LD + 31 * PL + 8 * oct), x1 = *(const LAS f32x4*)(LD + 31 * PL + 8 * oct + 4);
                ld[0] += x0.x; ld[1] += x0.y; ld[2] += x0.z; ld[3] += x0.w; ld[4] += x1.x; ld[5] += x1.y; ld[6] += x1.z; ld[7] += x1.w; }
            float kav[8], rkv[8];
            { const f32x4 m0_ = *(const LAS f32x4*)(CST + 384 + 8 * oct), m1_ = *(const LAS f32x4*)(CST + 384 + 8 * oct + 4); kav[0] = m0_.x; kav[1] = m0_.y; kav[2] = m0_.z; kav[3] = m0_.w; kav[4] = m1_.x; kav[5] = m1_.y; kav[6] = m1_.z; kav[7] = m1_.w; }
            { const f32x4 m0_ = *(const LAS f32x4*)(CST + 448 + 8 * oct), m1_ = *(const LAS f32x4*)(CST + 448 + 8 * oct + 4); rkv[0] = m0_.x; rkv[1] = m0_.y; rkv[2] = m0_.z; rkv[3] = m0_.w; rkv[4] = m1_.x; rkv[5] = m1_.y; rkv[6] = m1_.z; rkv[7] = m1_.w; }
            float at[8], rt[8], bt[8], kt[8]; float bon = 0.f;
#pragma unroll
            for (int j = 0; j < 8; ++j) {
                const float dinc = __expf(ld[j]), dinv = __builtin_amdgcn_rcpf(dinc), dexc = dinc * __expf(-lw[j]);
                const float kd = kp[j] * (1.0f + (a[j] - 1.0f) * kav[j]);
                at[j] = -kk[j] * dexc; rt[j] = rp[j] * dinc; bt[j] = kk[j] * a[j] * dinv; kt[j] = kd * dinv;
                bon += rp[j] * kd * rkv[j];
                if (tau == 63) DL[8 * oct + j] = dinc;
            }
            { u32x4 w; w.x = pk2(at[0], at[1]); w.y = pk2(at[2], at[3]); w.z = pk2(at[4], at[5]); w.w = pk2(at[6], at[7]); *(LAS u32x4*)(At + tau * P + 8 * oct) = w; }
            { u32x4 w; w.x = pk2(rt[0], rt[1]); w.y = pk2(rt[2], rt[3]); w.z = pk2(rt[4], rt[5]); w.w = pk2(rt[6], rt[7]); *(LAS u32x4*)(Rt + tau * P + 8 * oct) = w; }
            { u32x4 w; w.x = pk2(bt[0], bt[1]); w.y = pk2(bt[2], bt[3]); w.z = pk2(bt[4], bt[5]); w.w = pk2(bt[6], bt[7]); *(LAS u32x4*)(Btk + tau * P + 8 * oct) = w; }
            { u32x4 w; w.x = pk2(kt[0], kt[1]); w.y = pk2(kt[2], kt[3]); w.z = pk2(kt[4], kt[5]); w.w = pk2(kt[6], kt[7]); *(LAS u32x4*)(Ktk + tau * P + 8 * oct) = w; }
#pragma unroll
            for (int j = 0; j < 8; ++j) { Bkj[(8 * oct + j) * P + tau] = (bf16)f2bf(bt[j]); Kkj[(8 * oct + j) * P + tau] = (bf16)f2bf(kt[j]); }
            bon = sum8(bon);
            if (oct == 0) { const int tq = r ? T - 1 - (64 * ci + tau) : 64 * ci + tau; BON[((size_t)r * M + rowbase + tq) * 8 + h] = bon; }
        }
        LDS_BARRIER();
        {
            int tl_ = tid; asm volatile("" : "+v"(tl_)); const int lane = tl_ & 63, fr = lane & 15, fq = lane >> 4, tau = tl_ >> 3, oct = tl_ & 7; (void)lane; (void)fr; (void)fq; (void)tau; (void)oct;
            const int tcol = 16 * ntW + fr;
            if (wave == 4 || wave == 5) {
                unsigned zz_; asm volatile("v_mov_b32 %0, 0" : "=v"(zz_)); const u32x2 z2 = (u32x2){zz_, zz_};
#pragma unroll
                for (int t = 0; t < 2; ++t) { const int o = tcol * P + 16 * (2 + t) + 4 * fq; *(LAS u32x2*)(MkT + o) = z2; *(LAS u32x2*)(NbT + o) = z2; *(LAS u32x2*)(NkT + o) = z2; *(LAS u32x2*)(Mbj + o) = z2; }
                const int a0 = 2 * (wave - 4);
#pragma unroll
                for (int t = 0; t < 2; ++t) { const int ab = a0 + t;
                    f32x4 mb = (f32x4){0.f, 0.f, 0.f, 0.f};
#pragma unroll
                    for (int ks = 0; ks < 2; ++ks) mb = MFMA16(FR(Btk, 16 * ab + fr, ks), FR(At, 16 * ab + fr, ks), mb);
#pragma unroll
                    for (int i = 0; i < 4; ++i) MD[(ab * 16 + 4 * fq + i) * 16 + fr] = (4 * fq + i < fr) ? mb[i] : 0.f; }
                asm volatile("s_waitcnt lgkmcnt(0)" ::: "memory");
                const int a = a0 + (fq >> 1), n = fr;
                float x[16];
#pragma unroll
                for (int i = 0; i < 16; ++i) x[i] = (i == n) ? 1.f : 0.f;
#pragma unroll
                for (int i = 14; i >= 0; --i) {
                    float m[16];
#pragma unroll
                    for (int q = 0; q < 4; ++q) { if (4 * q + 3 > i) { const f32x4 v4 = *(const LAS f32x4*)(MD + (a * 16 + i) * 16 + 4 * q); m[4 * q] = v4.x; m[4 * q + 1] = v4.y; m[4 * q + 2] = v4.z; m[4 * q + 3] = v4.w; } else { m[4 * q] = 0.f; m[4 * q + 1] = 0.f; m[4 * q + 2] = 0.f; m[4 * q + 3] = 0.f; } }
                    float s0 = (i == n) ? 1.f : 0.f;
#pragma unroll
                    for (int j = i + 1; j < 16; ++j) s0 += m[j] * x[j];
                    x[i] = s0;
                    asm volatile("" ::: "memory");
                }
                u32x4 w0_, w1_; w0_.x = pk2(x[0], x[1]); w0_.y = pk2(x[2], x[3]); w0_.z = pk2(x[4], x[5]); w0_.w = pk2(x[6], x[7]); w1_.x = pk2(x[8], x[9]); w1_.y = pk2(x[10], x[11]); w1_.z = pk2(x[12], x[13]); w1_.w = pk2(x[14], x[15]);
                if ((fq & 1) == 0) { *(LAS u32x4*)(TT + (16 * a + n) * P + 16 * a) = w0_; *(LAS u32x4*)(TT + (16 * a + n) * P + 16 * a + 8) = w1_; }
            } else {
                bf16x8 bA[2], bR[2];
#pragma unroll
                for (int ks = 0; ks < 2; ++ks) { bA[ks] = FR(At, 16 * ntW + fr, ks); bR[ks] = FR(Rt, 16 * ntW + fr, ks); }
#pragma unroll
                for (int t = 0; t < 2; ++t) {
                    const int mt = mt0 + t;
                    const int o = tcol * P + 16 * mt + 4 * fq;
                    if (mt > ntW) {
                        unsigned zz_; asm volatile("v_mov_b32 %0, 0" : "=v"(zz_)); const u32x2 z2 = (u32x2){zz_, zz_};
                        *(LAS u32x2*)(MkT + o) = z2; *(LAS u32x2*)(NbT + o) = z2; *(LAS u32x2*)(NkT + o) = z2; *(LAS u32x2*)(Mbj + o) = z2;
                    } else {
                        bf16x8 aB[2], aK[2];
#pragma unroll
                        for (int ks = 0; ks < 2; ++ks) { aB[ks] = FR(Btk, 16 * mt + fr, ks); aK[ks] = FR(Ktk, 16 * mt + fr, ks); }
                        f32x4 mk = (f32x4){0.f, 0.f, 0.f, 0.f}, nb = mk, nk = mk, mb = mk;
#pragma unroll
                        for (int ks = 0; ks < 2; ++ks) { mk = MFMA16(aK[ks], bA[ks], mk); nb = MFMA16(aB[ks], bR[ks], nb); nk = MFMA16(aK[ks], bR[ks], nk); mb = MFMA16(aB[ks], bA[ks], mb); }
                        if (mt == ntW) {
#pragma unroll
                            for (int i = 0; i < 4; ++i) { const int jl = 4 * fq + i; if (!(jl < fr)) { mk[i] = 0.f; mb[i] = 0.f; } if (!(jl <= fr)) { nb[i] = 0.f; nk[i] = 0.f; } } }
                        *(LAS u32x2*)(MkT + o) = pack4bf(mk); *(LAS u32x2*)(NbT + o) = pack4bf(nb); *(LAS u32x2*)(NkT + o) = pack4bf(nk); *(LAS u32x2*)(Mbj + o) = pack4bf(mb);
                    }
                }
            }
        }
        LDS_BARRIER();
        if (ci + 1 < nch) RW_LOAD(ci + 1);
        f32x4 y0[2];
        {
            int tl_ = tid; asm volatile("" : "+v"(tl_)); const int lane = tl_ & 63, fr = lane & 15, fq = lane >> 4, tau = tl_ >> 3, oct = tl_ & 7; (void)lane; (void)fr; (void)fq; (void)tau; (void)oct;
            bf16x8 bS[2], bV[2];
#pragma unroll
            for (int ks = 0; ks < 2; ++ks) { bS[ks] = FR(Svk, 16 * ntW + fr, ks); bV[ks] = FR(Vvj, 16 * ntW + fr, ks); }
            f32x4 xa[4];
#pragma unroll
            for (int bb = 0; bb < 4; ++bb) { xa[bb] = (f32x4){0.f, 0.f, 0.f, 0.f};
#pragma unroll
                for (int ks = 0; ks < 2; ++ks) { xa[bb] = MFMA16(FR(At, 16 * bb + fr, ks), bS[ks], xa[bb]); xa[bb] = MFMA16(FR(MkT, 16 * bb + fr, ks), bV[ks], xa[bb]); } }
            u32x2 up[4];
#pragma unroll
            for (int bb = 0; bb < 4; ++bb) {
                f32x4 w = xa[bb];
#pragma unroll
                for (int c = 0; c < 4; ++c) if (c < bb) {
                    const u32x2 am = *(const LAS u32x2*)(Mbj + (16 * bb + fr) * P + 16 * c + 4 * fq);
                    w = MFMA16(__builtin_bit_cast(bf16x8, ((u32x4){am.x, am.y, 0u, 0u})), __builtin_bit_cast(bf16x8, ((u32x4){up[c].x, up[c].y, 0u, 0u})), w);
                }
                const u32x2 wp = pack4bf(w);
                const u32x2 at = *(const LAS u32x2*)(TT + (16 * bb + fr) * P + 16 * bb + 4 * fq);
                const f32x4 ub = MFMA16(__builtin_bit_cast(bf16x8, ((u32x4){at.x, at.y, 0u, 0u})), __builtin_bit_cast(bf16x8, ((u32x4){wp.x, wp.y, 0u, 0u})), ((f32x4){0.f, 0.f, 0.f, 0.f}));
                up[bb] = pack4bf(ub);
            }
#pragma unroll
            for (int t = 0; t < 2; ++t) *(LAS u32x2*)(Uvj + (16 * ntW + fr) * P + 16 * (mt0 + t) + 4 * fq) = (t == 0 ? (mt0 == 0 ? up[0] : up[2]) : (mt0 == 0 ? up[1] : up[3]));
            bf16x8 bR[2], bN[2];
#pragma unroll
            for (int ks = 0; ks < 2; ++ks) { bR[ks] = FR(Rt, 16 * ntW + fr, ks); bN[ks] = FR(NkT, 16 * ntW + fr, ks); }
#pragma unroll
            for (int t = 0; t < 2; ++t) {
                const int mt = mt0 + t;
                f32x4 yy = (f32x4){0.f, 0.f, 0.f, 0.f};
#pragma unroll
                for (int ks = 0; ks < 2; ++ks) { yy = MFMA16(FR(Svk, 16 * mt + fr, ks), bR[ks], yy); yy = MFMA16(FR(Vvj, 16 * mt + fr, ks), bN[ks], yy); }
                y0[t] = yy;
            }
        }
        LDS_BARRIER();
        {
            int tl_ = tid; asm volatile("" : "+v"(tl_)); const int lane = tl_ & 63, fr = lane & 15, fq = lane >> 4, tau = tl_ >> 3, oct = tl_ & 7; (void)lane; (void)fr; (void)fq; (void)tau; (void)oct;
            bf16x8 bNb[2], bU[2], bV[2];
#pragma unroll
            for (int ks = 0; ks < 2; ++ks) { bNb[ks] = FR(NbT, 16 * ntW + fr, ks); bU[ks] = FR(Uvj, 16 * ntW + fr, ks); bV[ks] = FR(Vvj, 16 * ntW + fr, ks); }
            const int tt = 16 * ntW + fr;
            const int tq = r ? T - 1 - (64 * ci + tt) : 64 * ci + tt;
            bf16* yrow = YS + ((size_t)r * M + rowbase + tq) * 384 + 64 * h;
#pragma unroll
            for (int t = 0; t < 2; ++t) {
                const int mt = mt0 + t;
                f32x4 yy = y0[t];
#pragma unroll
                for (int ks = 0; ks < 2; ++ks) yy = MFMA16(FR(Uvj, 16 * mt + fr, ks), bNb[ks], yy);
                *(u32x2*)(yrow + 16 * mt + 4 * fq) = pack4bf(yy);
                f32x4 sacc = Sacc[t];
#pragma unroll
                for (int ks = 0; ks < 2; ++ks) { sacc = MFMA16(FR(Bkj, 16 * mt + fr, ks), bU[ks], sacc); sacc = MFMA16(FR(Kkj, 16 * mt + fr, ks), bV[ks], sacc); }
                sacc = sacc * *(const LAS f32x4*)(DL + 16 * mt + 4 * fq);
                Sacc[t] = sacc;
            }
        }
        LDS_BARRIER();
        {
            int tl_ = tid; asm volatile("" : "+v"(tl_)); const int fr = tl_ & 15, fq = (tl_ & 63) >> 4;
#pragma unroll
            for (int t = 0; t < 2; ++t) *(LAS u32x2*)(Svk + (16 * ntW + fr) * P + 16 * (mt0 + t) + 4 * fq) = pack4bf(Sacc[t]);
        }
    }
#undef FR
#undef RW_LOAD
#undef UNPK
#undef MIX8
    if (sout_idx >= 0) {
        float* Sout = Sout_base + (size_t)sout_idx * 4096;
        int tl_ = tid; asm volatile("" : "+v"(tl_)); const int fr = tl_ & 15, fq = (tl_ & 63) >> 4;
#pragma unroll
        for (int t = 0; t < 2; ++t) *(f32x4*)(Sout + (16 * ntW + fr) * 64 + 16 * (mt0 + t) + 4 * fq) = Sacc[t];
    }
    LDS_BARRIER();
}

__device__ __forceinline__ void fin_stage_g2(LAS unsigned char* lds, const float* g2, int tid) {
    LAS bf16* G2T = (LAS bf16*)lds;
    for (int e = tid; e < 384 * 16; e += NTHR) {
        const int c = e % 384, jo = e / 384;
        float a[8];
#pragma unroll
        for (int j = 0; j < 8; ++j) a[j] = g2[(size_t)(8 * jo + j) * 384 + c];
        u32x4 w; w.x = pk2(a[0], a[1]); w.y = pk2(a[2], a[3]); w.z = pk2(a[4], a[5]); w.w = pk2(a[6], a[7]); *(LAS u32x4*)(G2T + c * 136 + 8 * jo) = w;
    }
}
__device__ __forceinline__ void unit_fin(LAS unsigned char* lds, bf16* Z, const bf16* HS, const bf16* YS, const float* BON, const float* mu, const float* ln_g, const float* out_g, int ft, int tid) {
    constexpr int PG = 136;
    LAS bf16* G2T = (LAS bf16*)lds;
    LAS bf16* SGb = G2T + 384 * PG;
    const int wave = __builtin_amdgcn_readfirstlane(tid >> 6), lane = tid & 63, fr = lane & 15, fq = lane >> 4;
    {
        const int tau = tid >> 3, oct = tid & 7;
        const size_t m = (size_t)ft * 64 + tau;
        const int tq = m < MCTX ? (int)(m & (TCTX - 1)) : (int)((m - MCTX) & (TLAT - 1)); const int T = m < MCTX ? TCTX : TLAT;
        const bf16* zr = Z + m * ZP;
#pragma unroll
        for (int hf = 0; hf < 2; ++hf) {
            float x[8]; shiftmix8(zr, OFF_C + 1408 + 16 * oct + 8 * hf, tq > 0, tq < T - 1, mu, x);
            u32x4 w; w.x = pk2(sigmoidf_(x[0]), sigmoidf_(x[1])); w.y = pk2(sigmoidf_(x[2]), sigmoidf_(x[3])); w.z = pk2(sigmoidf_(x[4]), sigmoidf_(x[5])); w.w = pk2(sigmoidf_(x[6]), sigmoidf_(x[7]));
            *(LAS u32x4*)(SGb + tau * PG + 16 * oct + 8 * hf) = w;
        }
    }
    __syncthreads();
    const int nt = wave & 3, h0 = 3 * (wave >> 2);
    const int tau = 16 * nt + fr;
    const size_t m = (size_t)ft * 64 + tau;
    const int tq = m < MCTX ? (int)(m & (TCTX - 1)) : (int)((m - MCTX) & (TLAT - 1)); const int T = m < MCTX ? TCTX : TLAT;
    const bool hasp = tq > 0, hasn = tq < T - 1;
    bf16* zr = Z + m * ZP;
    bf16x8 bsg[4];
#pragma unroll
    for (int ks = 0; ks < 4; ++ks) bsg[ks] = *(const LAS bf16x8*)(SGb + tau * PG + 32 * ks + 8 * fq);
#pragma unroll 1
    for (int hh = 0; hh < 3; ++hh) {
        const int h = h0 + hh;
        f32x4 g[4];
#pragma unroll
        for (int ct = 0; ct < 4; ++ct) { g[ct] = (f32x4){0.f, 0.f, 0.f, 0.f};
#pragma unroll
            for (int ks = 0; ks < 4; ++ks) g[ct] = MFMA16(*(const LAS bf16x8*)(G2T + (64 * h + 16 * ct + fr) * PG + 32 * ks + 8 * fq), bsg[ks], g[ct]); }
        const float bon = BON[((size_t)0 * M + m) * 8 + h] + BON[((size_t)1 * M + m) * 8 + h];
        {
            float y[4][4]; float s = 0.f;
#pragma unroll
            for (int ct = 0; ct < 4; ++ct) { const int c = 64 * h + 16 * ct + 4 * fq;
                const u32x2 a = *(const u32x2*)(YS + ((size_t)0 * M + m) * 384 + c), b = *(const u32x2*)(YS + ((size_t)1 * M + m) * 384 + c);
                y[ct][0] = __uint_as_float(a.x << 16) + __uint_as_float(b.x << 16); y[ct][1] = __uint_as_float(a.x & 0xffff0000u) + __uint_as_float(b.x & 0xffff0000u);
                y[ct][2] = __uint_as_float(a.y << 16) + __uint_as_float(b.y << 16); y[ct][3] = __uint_as_float(a.y & 0xffff0000u) + __uint_as_float(b.y & 0xffff0000u);
                s += (y[ct][0] + y[ct][1]) + (y[ct][2] + y[ct][3]); }
            s += bperm(s, lane ^ 16); s += bperm(s, lane ^ 32);
            const float mean = s * (1.f / 64.f); float q = 0.f;
#pragma unroll
            for (int ct = 0; ct < 4; ++ct)
#pragma unroll
                for (int i = 0; i < 4; ++i) { y[ct][i] -= mean; q += y[ct][i] * y[ct][i]; }
            q += bperm(q, lane ^ 16); q += bperm(q, lane ^ 32);
            const float rstd = rsqrtf(q * (1.f / 64.f) + 1e-5f);
#pragma unroll
            for (int ct = 0; ct < 4; ++ct) { const int c = 64 * h + 16 * ct + 4 * fq;
                const f32x4 lg = *(const f32x4*)(ln_g + c), mv = *(const f32x4*)(mu + 768 + c);
                const int col = OFF_C + 768 + c;
                const u32x2 vc = *(const u32x2*)(zr + col); u32x2 vp = (u32x2){0u, 0u}, vn = (u32x2){0u, 0u};
                if (hasp) vp = *(const u32x2*)(zr - ZP + col);
                if (hasn) vn = *(const u32x2*)(zr + ZP + col);
                const float cv[4] = {__uint_as_float(vc.x << 16), __uint_as_float(vc.x & 0xffff0000u), __uint_as_float(vc.y << 16), __uint_as_float(vc.y & 0xffff0000u)};
                const float pv[4] = {__uint_as_float(vp.x << 16), __uint_as_float(vp.x & 0xffff0000u), __uint_as_float(vp.y << 16), __uint_as_float(vp.y & 0xffff0000u)};
                const float nv[4] = {__uint_as_float(vn.x << 16), __uint_as_float(vn.x & 0xffff0000u), __uint_as_float(vn.y << 16), __uint_as_float(vn.y & 0xffff0000u)};
                f32x4 o;
#pragma unroll
                for (int i = 0; i < 4; ++i) { const float vs = cv[i] + mv[i] * (0.5f * (pv[i] + nv[i]) - cv[i]); o[i] = (y[ct][i] * rstd * lg[i] + bon * vs) * g[ct][i]; }
                *(u32x2*)(zr + YC_OFF + c) = pack4bf(o); }
        }
        {
            float y[4][4]; float s = 0.f;
#pragma unroll
            for (int ct = 0; ct < 4; ++ct) { const int c = 64 * h + 16 * ct + 4 * fq;
                const u32x2 a = *(const u32x2*)(HS + ((size_t)0 * M + m) * 384 + c), b = *(const u32x2*)(HS + ((size_t)1 * M + m) * 384 + c);
                y[ct][0] = __uint_as_float(a.x << 16) + __uint_as_float(b.x << 16); y[ct][1] = __uint_as_float(a.x & 0xffff0000u) + __uint_as_float(b.x & 0xffff0000u);
                y[ct][2] = __uint_as_float(a.y << 16) + __uint_as_float(b.y << 16); y[ct][3] = __uint_as_float(a.y & 0xffff0000u) + __uint_as_float(b.y & 0xffff0000u);
                s += (y[ct][0] + y[ct][1]) + (y[ct][2] + y[ct][3]); }
            s += bperm(s, lane ^ 16); s += bperm(s, lane ^ 32);
            const float mean = s * (1.f / 64.f); float q = 0.f;
#pragma unroll
            for (int ct = 0; ct < 4; ++ct)
#pragma unroll
                for (int i = 0; i < 4; ++i) { y[ct][i] -= mean; q += y[ct][i] * y[ct][i]; }
            q += bperm(q, lane ^ 16); q += bperm(q, lane ^ 32);
            const float rstd = rsqrtf(q * (1.f / 64.f) + 1e-5f);
#pragma unroll
            for (int ct = 0; ct < 4; ++ct) { const int c = 64 * h + 16 * ct + 4 * fq;
                const f32x4 og = *(const f32x4*)(out_g + c);
                const u32x2 ov = *(const u32x2*)(zr + OFF_O + c);
                const float oo[4] = {__uint_as_float(ov.x << 16), __uint_as_float(ov.x & 0xffff0000u), __uint_as_float(ov.y << 16), __uint_as_float(ov.y & 0xffff0000u)};
                f32x4 o;
#pragma unroll
                for (int i = 0; i < 4; ++i) o[i] = y[ct][i] * rstd * og[i] * sigmoidf_(oo[i]);
                *(u32x2*)(zr + YB_OFF + c) = pack4bf(o); }
        }
    }
    __syncthreads();
}

constexpr int NR = 96, NC = 160;
constexpr size_t XNC_OFF = (size_t)2 * M * 384 * 2;
constexpr size_t HIDC_BACK = 2 * MiB;
static_assert(XNC_OFF + (size_t)MCTX * D * 2 + HIDC_BACK <= (size_t)M * D * 2 && (size_t)MCTX * FF * 2 == HIDC_BACK + (size_t)MCTX * ZP * 2, "context overlays");
#define PHASE_TID() int tid; asm volatile("v_mbcnt_lo_u32_b32 %0, -1, 0\n\tv_mbcnt_hi_u32_b32 %0, -1, %0" : "=v"(tid)); tid += wave0 * 64; \
    const int lane = tid & 63, wave = __builtin_amdgcn_readfirstlane(tid >> 6); (void)lane; (void)wave
struct Args { const float* in[33]; float* out; unsigned char* ws; int pad0, pad1; };
static_assert(sizeof(Args) == 33 * 8 + 8 + 8 + 8, "Args has no padding");

__global__ void __launch_bounds__(NTHR, 2) fwd(Args args) {
    extern __shared__ __attribute__((aligned(16))) unsigned char lds_raw[];
    LAS unsigned char* lds = (LAS unsigned char*)lds_raw;
    volatile LAS unsigned* MISC = (volatile LAS unsigned*)(lds + MISC_OFF);
    const int tid0 = threadIdx.x;
    const int wave0 = __builtin_amdgcn_readfirstlane(tid0 >> 6);
    const int G = gridDim.x, bid = blockIdx.x;
    const bool isR = bid < NR;
    unsigned char* ws = args.ws;
    unsigned* ctl = (unsigned*)(ws + WS_CTL);
    float* MOD = (float*)(ws + WS_MOD);
    float* BON = (float*)(ws + WS_BON);
    bf16* ACT = (bf16*)(ws + WS_ACT);
    bf16* XNC = (bf16*)(ws + WS_ACT + XNC_OFF);
    bf16* Zb = (bf16*)(ws + WS_Z);
    bf16* YSb = (bf16*)(ws + WS_YS);
    bf16* HSb = ACT;
    bf16* HID = Zb;
    bf16* HIDC = (bf16*)(ws + WS_Z - HIDC_BACK);
    float* out = args.out;
    const float* x_prompt = args.in[0]; const float* x_sample = args.in[1];

    if (tid0 < 64) MISC[tid0] = 0u;
    __syncthreads();
    XcdBarrier gbar = xcd_barrier_post(ctl + CW_BAR, MISC + 8, (unsigned)G, true);
    XcdBarrier cbar = xcd_barrier_post(ctl + CW_BAR + XCD_BAR_WORDS, MISC + 10, (unsigned)NC, !isR);

    enum { K_W = 0, K_N1 = 1, K_IN = 2, K_Q = 3, K_FIN = 4, K_OUT = 5, K_N2 = 6, K_UP = 7, K_DOWN = 8, K_FINAL = 9 };
    for (int st = 0; st < 28; ++st) {
        int kind, l, rows, grp, seam;
        switch (st) {
            case 0:  kind = K_W;    l = 0; rows = 0; grp = 0; seam = 1; break;
            case 1:  kind = K_N1;   l = 0; rows = 0; grp = 0; seam = 1; break;
            case 2:  kind = K_IN;   l = 0; rows = 0; grp = 0; seam = 1; break;
            case 3:  kind = K_Q;    l = 0; rows = 1; grp = 2; seam = 2; break;
            case 4:  kind = K_FIN;  l = 0; rows = 1; grp = 1; seam = 2; break;
            case 5:  kind = K_OUT;  l = 0; rows = 1; grp = 1; seam = 2; break;
            case 6:  kind = K_N2;   l = 0; rows = 1; grp = 1; seam = 2; break;
            case 7:  kind = K_UP;   l = 0; rows = 1; grp = 1; seam = 1; break;
            case 8:  kind = K_FIN;  l = 0; rows = 2; grp = 0; seam = 1; break;
            case 9:  kind = K_OUT;  l = 0; rows = 2; grp = 0; seam = 1; break;
            case 10: kind = K_N2;   l = 0; rows = 2; grp = 0; seam = 1; break;
            case 11: kind = K_UP;   l = 0; rows = 2; grp = 0; seam = 1; break;
            case 12: kind = K_DOWN; l = 0; rows = 2; grp = 0; seam = 1; break;
            case 13: kind = K_N1;   l = 1; rows = 2; grp = 0; seam = 1; break;
            case 14: kind = K_IN;   l = 1; rows = 2; grp = 3; seam = 1; break;
            case 15: kind = K_N1;   l = 1; rows = 1; grp = 0; seam = 1; break;
            case 16: kind = K_IN;   l = 1; rows = 1; grp = 0; seam = 1; break;
            case 17: kind = K_Q;    l = 1; rows = 1; grp = 2; seam = 2; break;
            case 18: kind = K_FIN;  l = 1; rows = 1; grp = 1; seam = 2; break;
            case 19: kind = K_OUT;  l = 1; rows = 1; grp = 1; seam = 2; break;
            case 20: kind = K_N2;   l = 1; rows = 1; grp = 1; seam = 2; break;
            case 21: kind = K_UP;   l = 1; rows = 1; grp = 1; seam = 1; break;
            case 22: kind = K_FIN;  l = 1; rows = 2; grp = 3; seam = 1; break;
            case 23: kind = K_OUT;  l = 1; rows = 2; grp = 0; seam = 1; break;
            case 24: kind = K_N2;   l = 1; rows = 2; grp = 0; seam = 1; break;
            case 25: kind = K_UP;   l = 1; rows = 2; grp = 0; seam = 1; break;
            case 26: kind = K_DOWN; l = 1; rows = 2; grp = 0; seam = 1; break;
            default: kind = K_FINAL; l = 1; rows = 0; grp = 0; seam = 0; break;
        }
        int Gs = G, cb = bid; bool active = true;
        if (grp == 1) { Gs = NC; cb = bid - NR; active = !isR; }
        else if (grp == 2) { Gs = NC; cb = bid - NR; }
        else if (grp == 3) { if (bid < 64) { kind = K_DOWN; rows = 1; Gs = 64; cb = bid; if (st == 14) l = 0; } else { Gs = G - 64; cb = bid - 64; } }
        const int pm0 = rows == 2 ? 16 : 0, mtl = rows == 0 ? 80 : (rows == 1 ? 16 : 64);
        const int m_lo = pm0 * 256, m_hi = m_lo + mtl * 256;
        bf16* XNg = rows == 0 ? ACT : (rows == 2 ? ACT - (size_t)MCTX * D : XNC);
        const bf16* XNa = rows == 1 ? XNC : ACT;
        if (active) {
            const float* MODl = MOD + (size_t)l * NMODC * 6144;
            if (kind == K_W) {
                PHASE_TID();
                const int vcu = (G % 8 == 0) ? (bid % 8) * (G / 8) + bid / 8 : bid;
                phase_weights(lds, args.in[12], args.in[13], args.in[30], args.in[31], ws + WS_W, vcu * NWAVES + wave, WI_IN, G * NWAVES, wave, lane);
                __syncthreads(); phase_mod(lds, args.in[2], args.in[7], args.in[10], args.in[11], MOD, tid, bid, G);
            } else if (kind == K_N1) {
                PHASE_TID();
                phase_norm(l == 0 ? x_prompt : out, l == 0 ? x_sample : out + (size_t)MCTX * D, args.in[8] + l * D, MODl, 0, 1024, XNg, m_lo, m_hi, cb * NWAVES + wave, Gs * NWAVES, lane);
            } else if (kind == K_FINAL) {
                PHASE_TID();
                phase_final_norm(out, args.in[32], m_lo, m_hi, cb * NWAVES + wave, Gs * NWAVES, lane);
            } else if (kind == K_IN) {
                PHASE_TID();
                pg8::Gemm g{XNa, (const bf16*)(ws + WS_W + WOFF_IN), mtl * 256, ZP, D, D}; pg8::StaticOrder S; S.init(mtl * 256, ZP, Gs, cb);
                pg8::EpiBf16<0> E{Zb + (size_t)m_lo * ZP, ZP};
                pg8::gemm_phase<pg8::EpiBf16<0>, pg8::StaticOrder, true, true>(lds, g, S, E, tid);
            } else if (kind == K_Q) {
                unsigned* counter = ctl + CW_WORK + 64 * l;
                const int nwu = l == 0 ? (WI_ALL + 31) / 32 : (WI_ALL - WI_IN + 31) / 32, wbase = l == 0 ? 0 : WI_IN;
                const int ulim = 1120 + nwu;
                for (;;) {
                    int u;
                    if (isR) u = bid;
                    else {
                        __syncthreads();
                        { int t0_; asm volatile("v_mbcnt_lo_u32_b32 %0, -1, 0\n\tv_mbcnt_hi_u32_b32 %0, -1, %0" : "=v"(t0_));
                          if (wave0 == 0 && t0_ == 0) MISC[0] = __hip_atomic_fetch_add(counter, 1u, __ATOMIC_RELAXED, __HIP_MEMORY_SCOPE_AGENT); }
                        __syncthreads();
                        u = (int)MISC[0];
                        if (u >= ulim) break;
                    }
                    int tu; asm volatile("v_mbcnt_lo_u32_b32 %0, -1, 0\n\tv_mbcnt_hi_u32_b32 %0, -1, %0" : "=v"(tu)); tu += wave0 * 64;
                    if (isR || u < 480) {
                        const bool lat = isR || u < 96; const bool is_rwkv = isR || (u >= 96 && u < 288);
                        const int idx = isR ? u : (u < 96 ? u : (u < 288 ? u - 96 : u - 288));
                        const int b = idx / 12, rem = idx % 12, r = rem / 6, h = rem % 6;
                        const int T = lat ? TLAT : TCTX; const int rowbase = lat ? MCTX + b * TLAT : b * TCTX;
                        if (is_rwkv) {
                            const float* S0 = lat ? args.in[6] + ((((size_t)b * DEPTH + l) * 2 + r) * 6 + h) * 4096 : nullptr;
                            const int sout_idx = lat ? -1 : (((b * DEPTH + l) * 2 + r) * 6 + h);
                            unit_rwkv(lds, Zb, YSb, BON, args.in[20] + l * 1536, args.in[21] + l * 768, args.in[22] + (size_t)l * 2 * 64 * 384, args.in[23] + l * 768, args.in[24] + (size_t)l * 2 * 64 * 384,
                                      args.in[26] + l * 384, args.in[27] + l * 384, args.in[28] + l * 384, S0, out + (size_t)M * D + 1572864 + 24576 + 384, sout_idx, rowbase, T, r, h, tu);
                        } else {
                            const size_t sidx = (((size_t)b * DEPTH + l) * 2 + r) * 6 + h;
                            const float* C0 = lat ? args.in[3] + sidx * 4096 : nullptr; const float* n0 = lat ? args.in[4] + sidx * 64 : nullptr; const float* m0 = lat ? args.in[5] + sidx : nullptr;
                            float* Cout = lat ? nullptr : out + (size_t)M * D + sidx * 4096; float* nout = lat ? nullptr : out + (size_t)M * D + 1572864 + sidx * 64; float* mout = lat ? nullptr : out + (size_t)M * D + 1572864 + 24576 + sidx;
                            unit_mlstm(lds, Zb, HSb, args.in[17] + l * 3 * 768, args.in[18] + l * 24, C0, n0, m0, Cout, nout, mout, rowbase, T, r, h, tu);
                        }
                    } else if (u >= 1120) {
                        const int base = wbase + 32 * (u - 1120);
                        const int wv = __builtin_amdgcn_readfirstlane(tu >> 6);
                        phase_weights(lds, args.in[12] + (size_t)(l + 1 < DEPTH ? l + 1 : l) * D * INC, args.in[13] + (size_t)l * D * D, args.in[30] + (size_t)l * D * FF, args.in[31] + (size_t)l * FF * D, ws + WS_W,
                                      base + wv, (base + 32 < WI_ALL ? base + 32 : WI_ALL), 8, wv, tu & 63);
                    } else {
                        const int idx = u - 480;
                        unit_gmlp(lds, Zb, args.in[14] + l * 256, args.in[15] + (size_t)l * 4 * 128 * 128, args.in[16] + l * 4 * 128, idx >> 2, idx & 3, tu);
                    }
                    if (isR) break;
                }
            } else if (kind == K_FIN) {
                PHASE_TID();
                fin_stage_g2(lds, args.in[25] + (size_t)l * 128 * 384, tid);
                for (int ft = m_lo / 64 + cb; ft < m_hi / 64; ft += Gs)
                    unit_fin(lds, Zb, HSb, YSb, BON, args.in[20] + l * 1536, args.in[29] + l * 384, args.in[19] + l * 384, ft, tid);
            } else if (kind == K_OUT) {
                PHASE_TID();
                pg8::Gemm g{Zb + (size_t)m_lo * ZP, (const bf16*)(ws + WS_W + WOFF_OUT), mtl * 256, D, D, ZP}; pg8::StaticOrder S; S.init(mtl * 256, D, Gs, cb);
                pg8::EpiRes E{l == 0 ? x_prompt : out, l == 0 ? x_sample : out + (size_t)MCTX * D, out, MODl + 2048, pm0};
                pg8::gemm_phase<pg8::EpiRes, pg8::StaticOrder, true, true>(lds, g, S, E, tid);
            } else if (kind == K_N2) {
                PHASE_TID();
                phase_norm(out, out + (size_t)MCTX * D, args.in[9] + l * D, MODl, 3072, 4096, XNg, m_lo, m_hi, cb * NWAVES + wave, Gs * NWAVES, lane);
            } else if (kind == K_UP) {
                PHASE_TID();
                pg8::Gemm g{XNa, (const bf16*)(ws + WS_W + WOFF_W1), mtl * 256, FF, D, D}; pg8::StaticOrder S; S.init(mtl * 256, FF, Gs, cb);
                pg8::EpiBf16<2> E{rows == 1 ? HIDC : HID + (size_t)m_lo * FF, FF};
                pg8::gemm_phase<pg8::EpiBf16<2>, pg8::StaticOrder, true, true>(lds, g, S, E, tid);
            } else {
                PHASE_TID();
                pg8::Gemm g{rows == 1 ? HIDC : HID + (size_t)m_lo * FF, (const bf16*)(ws + WS_W + WOFF_W2), mtl * 256, D, FF, FF}; pg8::StaticOrder S; S.init(mtl * 256, D, Gs, cb);
                pg8::EpiRes E{out, out + (size_t)MCTX * D, out, MODl + 5120, pm0};
                pg8::gemm_phase<pg8::EpiRes, pg8::StaticOrder, true, true>(lds, g, S, E, tid);
            }
        }
        if (seam == 2) { if (!isR) xcd_barrier(cbar); }
        else if (seam == 1) xcd_barrier(gbar);
    }
}

extern "C" void kernel_launch(void* const* d_in, const int* in_sizes, int n_in, void* d_out, int out_size, void* d_ws, size_t ws_size, hipStream_t stream) {
    static int grid = 0;
    if (grid == 0) {
        if (n_in != 33 || ws_size < WS_END || out_size != M * D + 1572864 + 24576 + 384 + 1572864) { fprintf(stderr, "kernel_launch: unexpected problem (n_in %d, out %d, ws %zu)\n", n_in, out_size, ws_size); grid = -1; return; }
        int dev = 0, cus = 0;
        if (hipGetDevice(&dev) != hipSuccess || hipDeviceGetAttribute(&cus, hipDeviceAttributeMultiprocessorCount, dev) != hipSuccess) { grid = -1; return; }
        if (hipFuncSetAttribute((const void*)fwd, hipFuncAttributeMaxDynamicSharedMemorySize, LDS_BYTES) != hipSuccess) { fprintf(stderr, "kernel_launch: hipFuncSetAttribute failed\n"); grid = -1; return; }
        (void)hipGetLastError();
        grid = cus;
        if (grid != NR + NC) { fprintf(stderr, "kernel_launch: built for %d CUs\n", NR + NC); grid = -1; return; }
    }
    if (grid < 0) return;
    (void)hipMemsetAsync((char*)d_ws + WS_CTL, 0, CTL_ZERO_BYTES, stream);
    Args a{};
    for (int i = 0; i < 33; ++i) a.in[i] = (const float*)d_in[i];
    a.out = (float*)d_out; a.ws = (unsigned char*)d_ws;
    hipLaunchKernelGGL(fwd, dim3(grid), dim3(NTHR), LDS_BYTES, stream, a);
}
```

```cpp
#include <hip/hip_runtime.h>
#include <cstdio>
#include <cstdint>

#ifndef MK_SINGLE
#define MK_SINGLE 1
#endif

#define LAS __attribute__((address_space(3)))
#define GAS __attribute__((address_space(1)))
typedef unsigned short bf16;
typedef float f32x4 __attribute__((ext_vector_type(4)));
typedef float f32x2 __attribute__((ext_vector_type(2)));
typedef unsigned u32x4 __attribute__((ext_vector_type(4)));
typedef unsigned u32x2 __attribute__((ext_vector_type(2)));
typedef short bf16x8 __attribute__((ext_vector_type(8)));

constexpr int D = 1024, MCTX = 4096, TCTX = 256, TLAT = 2048, M = 20480, DEPTH = 2, NMODC = 9;
constexpr int INC = 3608, ZP = 3840, FF = 4096;
constexpr int OFF_QK = 512, OFF_V = 1280, OFF_O = 1664, OFF_G = 2048, OFF_C = 2072;
constexpr int YB_OFF = 256, YC_OFF = 640;
constexpr int NWAVES = 8, NTHR = 512;

constexpr size_t MiB = 1u << 20;
constexpr size_t WS_CTL = 0, CTL_ZERO_BYTES = 1 * MiB;
constexpr size_t WS_MOD = 1 * MiB;
constexpr size_t WS_BON = 2 * MiB;
constexpr size_t WS_W = 4 * MiB;
constexpr size_t WOFF_IN = 0, WOFF_OUT = (size_t)ZP * D * 2, WOFF_W1 = WOFF_OUT + (size_t)D * D * 2, WOFF_W2 = WOFF_W1 + (size_t)FF * D * 2;
constexpr size_t WS_ACT = 30 * MiB;
constexpr size_t WS_Z = 70 * MiB;
constexpr size_t WS_YS = 220 * MiB;
constexpr size_t WS_END = 250 * MiB;
static_assert(WS_W + WOFF_W2 + (size_t)D * FF * 2 <= WS_ACT, "weights");
static_assert(WS_ACT + (size_t)M * D * 2 <= WS_Z && WS_Z + (size_t)M * ZP * 2 <= WS_YS && WS_YS + (size_t)2 * M * 384 * 2 <= WS_END && WS_Z + (size_t)M * FF * 2 <= WS_END, "ws map");
constexpr int CW_WORK = 64;
constexpr int CW_BAR = 4096;
constexpr int LDS_BYTES = 163840;
constexpr int MISC_OFF = 160 * 1024 - 256;

__device__ __forceinline__ float bf2f(unsigned short u) { return __uint_as_float((unsigned)u << 16); }
typedef __bf16 bf16x2_t __attribute__((ext_vector_type(2)));
__device__ __forceinline__ unsigned pk2(float lo, float hi) { const f32x2 v = {lo, hi}; return __builtin_bit_cast(unsigned, __builtin_convertvector(v, bf16x2_t)); }
__device__ __forceinline__ unsigned f2bf(float f) { return pk2(f, 0.f) & 0xffffu; }
__device__ __forceinline__ void ld8(const bf16* p, float (&v)[8]) {
    const u32x4 w = *(const u32x4*)p;
    v[0] = __uint_as_float(w.x << 16); v[1] = __uint_as_float(w.x & 0xffff0000u); v[2] = __uint_as_float(w.y << 16); v[3] = __uint_as_float(w.y & 0xffff0000u);
    v[4] = __uint_as_float(w.z << 16); v[5] = __uint_as_float(w.z & 0xffff0000u); v[6] = __uint_as_float(w.w << 16); v[7] = __uint_as_float(w.w & 0xffff0000u);
}
__device__ __forceinline__ void st8(bf16* p, const float (&v)[8]) {
    u32x4 w; w.x = pk2(v[0], v[1]); w.y = pk2(v[2], v[3]); w.z = pk2(v[4], v[5]); w.w = pk2(v[6], v[7]); *(u32x4*)p = w;
}
__device__ __forceinline__ void ldf8(const float* p, float (&v)[8]) { const f32x4 a = *(const f32x4*)p, b = *(const f32x4*)(p + 4); v[0] = a.x; v[1] = a.y; v[2] = a.z; v[3] = a.w; v[4] = b.x; v[5] = b.y; v[6] = b.z; v[7] = b.w; }
__device__ __forceinline__ float sigmoidf_(float x) { return 1.0f / (1.0f + __expf(-x)); }
__device__ __forceinline__ float siluf_(float x) { return x / (1.0f + __expf(-x)); }
__device__ __forceinline__ float logsigf_(float x) { return fminf(x, 0.0f) - __logf(1.0f + __expf(-fabsf(x))); }
__device__ __forceinline__ float tanhf_(float x) { return 1.0f - 2.0f / (1.0f + __expf(2.0f * x)); }
__device__ __forceinline__ float geluf_(float x) { return 0.5f * x * (1.0f + tanhf_(0.7978845608028654f * (x + 0.044715f * x * x * x))); }
#define DPPX(x, ctrl) __uint_as_float(__builtin_amdgcn_update_dpp(0u, __float_as_uint(x), ctrl, 0xf, 0xf, true))
__device__ __forceinline__ float bperm(float v, int srclane) { return __uint_as_float((unsigned)__builtin_amdgcn_ds_bpermute(srclane << 2, (int)__float_as_uint(v))); }
__device__ __forceinline__ float sum4(float v) { v += DPPX(v, 0xB1); v += DPPX(v, 0x4E); return v; }
__device__ __forceinline__ float sum8(float v) { v += DPPX(v, 0xB1); v += DPPX(v, 0x4E); v += DPPX(v, 0x141); return v; }
__device__ __forceinline__ float wave_sum(float v, int lane) {
    v += DPPX(v, 0xB1); v += DPPX(v, 0x4E); v += DPPX(v, 0x141); v += DPPX(v, 0x140);
    v += bperm(v, lane ^ 16); v += bperm(v, lane ^ 32);
    return v;
}
__device__ __forceinline__ float dpp_sum16(float x) {
    x += __uint_as_float(__builtin_amdgcn_update_dpp(0u, __float_as_uint(x), 0xB1, 0xf, 0xf, true));
    x += __uint_as_float(__builtin_amdgcn_update_dpp(0u, __float_as_uint(x), 0x4E, 0xf, 0xf, true));
    x += __uint_as_float(__builtin_amdgcn_update_dpp(0u, __float_as_uint(x), 0x141, 0xf, 0xf, true));
    x += __uint_as_float(__builtin_amdgcn_update_dpp(0u, __float_as_uint(x), 0x140, 0xf, 0xf, true));
    return x;
}

namespace pg8 {
#define PG8_LAS __attribute__((address_space(3)))
typedef unsigned short bf16_t;
constexpr int BM = 256, BK = 64, HALF = 128, HTB = HALF * BK * 2, STAGE_BYTES = 8 * HTB, NXCD = 8, WGM = 8;
__host__ __device__ __forceinline__ int lds_byte(int r, int c) { const int st = (r >> 4) * 2 + (c >> 5), rr = r & 15, cc = c & 31, ob = rr * 64 + cc * 2; return st * 1024 + (ob ^ (((ob >> 9) & 1) << 5)); }
__host__ __device__ __forceinline__ void stage_rc(int b, int& R, int& C) { const int st = b / 1024, sb = b % 1024, swz = sb ^ (((sb >> 9) & 1) << 5); R = (st >> 1) * 16 + swz / 64; C = (st & 1) * 32 + (swz % 64) / 2; }
__host__ __device__ __forceinline__ int perm32(int rho) { const int n = rho >> 4, i = rho & 15; return 8 * (i >> 2) + 4 * n + (i & 3); }
struct Unit { int pm, pn; };
struct Gemm { const bf16_t* A; const bf16_t* Bt; int M, N, K, lda; };
struct StaticOrder {
    int nM, nN, nwg, G, c;
    __host__ __device__ void init(int M_, int N_, int G_, int c_) { nM = M_ / BM; nN = N_ / BM; nwg = nM * nN; G = G_; c = c_; }
    __host__ __device__ bool next(int i, Unit& u) const {
        const long L = (long)i * G + c; if (L >= nwg) return false;
        int wgid = (int)L; { const int q = nwg / NXCD, r = nwg % NXCD, xcd = wgid % NXCD, off = wgid / NXCD; wgid = (xcd < r ? xcd * (q + 1) : r * (q + 1) + (xcd - r) * q) + off; }
        const int nig = WGM * nN, gid = wgid / nig, fm = gid * WGM, gsz = (nM - fm) < WGM ? (nM - fm) : WGM;
        u.pm = fm + ((wgid % nig) % gsz); u.pn = (wgid % nig) / gsz; return true;
    }
    __device__ __forceinline__ void a_ready(const Unit&) const {}
    __device__ __forceinline__ void done(const Unit&) const {}
};
__device__ __forceinline__ unsigned cvt_pk_bf16(float lo, float hi) { unsigned r; asm volatile("v_cvt_pk_bf16_f32 %0, %1, %2" : "=v"(r) : "v"(lo), "v"(hi)); return r; }

template <int ACT  > struct EpiBf16 {
    static constexpr bool PERM = true, AFTER_DRAIN = false;
    bf16_t* O; int ldc;
    __device__ __forceinline__ void operator()(const f32x4 (&acc)[2][2][4][2], const Unit& u, int wr, int wc, int fr, int fq) const {
        const int row0 = u.pm * BM + wr * 64 + fr, col0 = u.pn * BM + wc * 32 + 8 * fq;
#pragma unroll
        for (int ai = 0; ai < 2; ++ai)
#pragma unroll
            for (int m = 0; m < 4; ++m) { bf16_t* rowp = O + (size_t)(row0 + ai * HALF + m * 16) * ldc + col0;
#pragma unroll
                for (int bj = 0; bj < 2; ++bj) { f32x4 v0 = acc[ai][bj][m][0], v1 = acc[ai][bj][m][1];
                    if (ACT == 2) {
#pragma unroll
                        for (int e = 0; e < 4; ++e) { const float a = fmaxf(v0[e], 0.f), b = fmaxf(v1[e], 0.f); v0[e] = a * a; v1[e] = b * b; } }
                    u32x4 w; w.x = cvt_pk_bf16(v0[0], v0[1]); w.y = cvt_pk_bf16(v0[2], v0[3]); w.z = cvt_pk_bf16(v1[0], v1[1]); w.w = cvt_pk_bf16(v1[2], v1[3]);
                    *(u32x4*)(rowp + bj * HALF) = w; } }
    }
};
struct EpiRes {
    static constexpr bool PERM = false, AFTER_DRAIN = false;
    const float* xin_c; const float* xin_l; float* xout; const float* gate; int pm0;
    __device__ __forceinline__ void operator()(const f32x4 (&acc)[2][2][4][2], const Unit& u, int wr, int wc, int fr, int fq) const {
        const int pm = u.pm + pm0, ci = pm < 16 ? 0 : 1 + ((pm - 16) >> 3);
        const float* xi = pm < 16 ? xin_c + (size_t)pm * 256 * D : xin_l + (size_t)(pm - 16) * 256 * D;
        float* xo = xout + (size_t)pm * 256 * D;
        const int rl0 = wr * 64 + fr, col0 = u.pn * BM + wc * 32 + 4 * fq;
        f32x4 gv[2][2];
#pragma unroll
        for (int bj = 0; bj < 2; ++bj)
#pragma unroll
            for (int n = 0; n < 2; ++n) gv[bj][n] = *(const f32x4*)(gate + ci * 6144 + col0 + bj * HALF + n * 16);
#pragma unroll
        for (int ai = 0; ai < 2; ++ai)
#pragma unroll
            for (int m = 0; m < 4; ++m) { const size_t ro = (size_t)(rl0 + ai * HALF + m * 16) * D + col0;
#pragma unroll
                for (int bj = 0; bj < 2; ++bj)
#pragma unroll
                    for (int n = 0; n < 2; ++n) { const size_t off = ro + bj * HALF + n * 16; const f32x4 xv = *(const f32x4*)(xi + off); *(f32x4*)(xo + off) = xv + gv[bj][n] * acc[ai][bj][m][n]; }
                if (m & 1) asm volatile("" ::: "memory"); }
    }
};

template <class Epi, class Sched, bool ALIGN_EPI = false, bool SP2 = false>
__device__ __forceinline__ void gemm_phase(PG8_LAS unsigned char* lds, const Gemm g, const Sched& S, const Epi& E, const int tid) {
    const int wid = __builtin_amdgcn_readfirstlane(tid >> 6), lane = tid & 63, wr = wid >> 2, wc = wid & 3, fr = lane & 15, fq = lane >> 4;
    const int K = g.K, nt = K / BK, lda = g.lda;
    unsigned voffA[2], voffB[2];
#pragma unroll
    for (int i = 0; i < 2; ++i) { int R, C; stage_rc(tid * 16 + i * 8192, R, C); const int Rb = Epi::PERM ? ((R & ~31) + perm32(R & 31)) : R;
        voffA[i] = (unsigned)(R * lda + C) * 2u; voffB[i] = (unsigned)(Rb * K + C) * 2u; }
    const size_t kstep = (size_t)(BK * 2);
    const size_t hstepA = (size_t)HALF * lda * 2, hstepB = (size_t)HALF * K * 2;
    const size_t tstepA = 2 * hstepA, tstepB = 2 * hstepB;
    const unsigned ldsw = (unsigned)wid * 1024u;
    const int aoff = lds_byte(wr * 64 + fr, fq * 8), boff = lds_byte(wc * 32 + fr, fq * 8);
#define PG8_SA(b, h) (((b) * 2 + (h)) * HTB)
#define PG8_SB(b, h) ((4 + (b) * 2 + (h)) * HTB)
#define PG8_STAGE(bufoff, gbase, voff) do { _Pragma("unroll") for (int _i = 0; _i < 2; ++_i) \
        __builtin_amdgcn_global_load_lds((const unsigned*)((const char*)(gbase) + (voff)[_i]), (PG8_LAS unsigned*)(lds + (bufoff) + ldsw + _i * 8192), 16, 0, 0); } while (0)
#define PG8_LDA(dst, b, h) do { _Pragma("unroll") for (int m = 0; m < 4; ++m) _Pragma("unroll") for (int k = 0; k < 2; ++k) dst[m][k] = *(const PG8_LAS bf16x8*)(lds + PG8_SA(b, h) + aoff + m * 2048 + k * 1024); } while (0)
#define PG8_LDB(dst, b, h) do { _Pragma("unroll") for (int n = 0; n < 2; ++n) _Pragma("unroll") for (int k = 0; k < 2; ++k) dst[n][k] = *(const PG8_LAS bf16x8*)(lds + PG8_SB(b, h) + boff + n * 2048 + k * 1024); } while (0)
#define PG8_MMA(ai, bj, At, Bt) do { __builtin_amdgcn_s_setprio(1); _Pragma("unroll") for (int m = 0; m < 4; ++m) _Pragma("unroll") for (int n = 0; n < 2; ++n) _Pragma("unroll") for (int k = 0; k < 2; ++k) \
        acc[ai][bj][m][n] = __builtin_amdgcn_mfma_f32_16x16x32_bf16(Bt[n][k], At[m][k], acc[ai][bj][m][n], 0, 0, 0); __builtin_amdgcn_s_setprio(0); } while (0)
#define PG8_WAIT_V(n) asm volatile("s_waitcnt vmcnt(" #n ")" ::: "memory")
#define PG8_WAIT_L(n) asm volatile("s_waitcnt lgkmcnt(" #n ")" ::: "memory")
#define PG8_BAR __builtin_amdgcn_s_barrier()
#define PG8_SCHED __builtin_amdgcn_sched_barrier(0)
    Unit cur, nxt; int ui = 0;
    if (!S.next(0, cur)) return;
    f32x4 acc[2][2][4][2];
#pragma unroll
    for (int a = 0; a < 2; ++a)
#pragma unroll
        for (int b = 0; b < 2; ++b)
#pragma unroll
            for (int m = 0; m < 4; ++m)
#pragma unroll
                for (int n = 0; n < 2; ++n) acc[a][b][m][n] = (f32x4){0.f, 0.f, 0.f, 0.f};
    bf16x8 At[4][2], B0[2][2], B1[2][2];
    const char* cA = (const char*)g.A + (size_t)cur.pm * tstepA; const char* cB = (const char*)g.Bt + (size_t)cur.pn * tstepB;
    S.a_ready(cur);
    if constexpr (SP2) {
        PG8_STAGE(PG8_SB(0, 0), cB, voffB); PG8_STAGE(PG8_SB(0, 1), cB + hstepB, voffB); PG8_STAGE(PG8_SA(0, 0), cA, voffA); PG8_STAGE(PG8_SA(0, 1), cA + hstepA, voffA);
        if (wr == 1) PG8_BAR;
        PG8_WAIT_V(2); PG8_BAR;
        PG8_STAGE(PG8_SB(1, 0), cB + kstep, voffB); PG8_STAGE(PG8_SA(1, 0), cA + kstep, voffA); PG8_STAGE(PG8_SB(1, 1), cB + hstepB + kstep, voffB);
        PG8_WAIT_V(6); PG8_BAR;
    } else {
        PG8_STAGE(PG8_SB(0, 0), cB, voffB); PG8_STAGE(PG8_SA(0, 0), cA, voffA); PG8_STAGE(PG8_SB(0, 1), cB + hstepB, voffB); PG8_STAGE(PG8_SA(0, 1), cA + hstepA, voffA);
        if (wr == 1) PG8_BAR;
        PG8_WAIT_V(4); PG8_BAR;
        PG8_STAGE(PG8_SB(1, 0), cB + kstep, voffB); PG8_STAGE(PG8_SA(1, 0), cA + kstep, voffA); PG8_STAGE(PG8_SB(1, 1), cB + hstepB + kstep, voffB);
        PG8_WAIT_V(6); PG8_BAR;
    }
    for (;;) {
        const bool has_next = S.next(ui + 1, nxt);
        const char* nA = has_next ? (const char*)g.A + (size_t)nxt.pm * tstepA : cA; const char* nB = has_next ? (const char*)g.Bt + (size_t)nxt.pn * tstepB : cB;
        for (int t = 0; t < nt; t += 2) {
            const bool last = (t == nt - 2);
            const char* a1 = cA + (size_t)(t + 1) * kstep;
            const char* a2 = last ? nA : cA + (size_t)(t + 2) * kstep; const char* b2 = last ? nB : cB + (size_t)(t + 2) * kstep;
            const char* a3 = a2 + kstep; const char* b3 = b2 + kstep;
            if (last && has_next) S.a_ready(nxt);
            if constexpr (SP2) {
            PG8_LDB(B0, 0, 0); PG8_LDB(B1, 0, 1); PG8_SCHED; PG8_LDA(At, 0, 0); PG8_STAGE(PG8_SA(1, 1), a1 + hstepA, voffA);
            PG8_WAIT_V(8); PG8_WAIT_L(0); PG8_BAR; PG8_MMA(0, 0, At, B0); PG8_MMA(0, 1, At, B1); PG8_BAR; PG8_SCHED;
            PG8_LDA(At, 0, 1); PG8_STAGE(PG8_SB(0, 0), b2, voffB); PG8_STAGE(PG8_SB(0, 1), b2 + hstepB, voffB); PG8_STAGE(PG8_SA(0, 0), a2, voffA);
            PG8_WAIT_V(8); PG8_WAIT_L(0); PG8_BAR; PG8_MMA(1, 0, At, B0); PG8_MMA(1, 1, At, B1); PG8_BAR; PG8_SCHED;
            PG8_LDB(B0, 1, 0); PG8_LDB(B1, 1, 1); PG8_SCHED; PG8_LDA(At, 1, 0); PG8_STAGE(PG8_SA(0, 1), a2 + hstepA, voffA);
            PG8_WAIT_V(8); PG8_WAIT_L(0); PG8_BAR; PG8_MMA(0, 0, At, B0); PG8_MMA(0, 1, At, B1); PG8_BAR; PG8_SCHED;
            PG8_LDA(At, 1, 1); PG8_STAGE(PG8_SB(1, 0), b3, voffB); PG8_STAGE(PG8_SB(1, 1), b3 + hstepB, voffB); PG8_STAGE(PG8_SA(1, 0), a3, voffA);
            PG8_WAIT_V(8); PG8_WAIT_L(0); PG8_BAR; PG8_MMA(1, 0, At, B0); PG8_MMA(1, 1, At, B1); PG8_BAR; PG8_SCHED;
            } else {
            PG8_LDB(B0, 0, 0); PG8_SCHED; PG8_LDA(At, 0, 0); PG8_STAGE(PG8_SA(1, 1), a1 + hstepA, voffA);
            PG8_WAIT_L(8); PG8_BAR; PG8_WAIT_L(0); PG8_MMA(0, 0, At, B0); PG8_BAR; PG8_SCHED;
            PG8_LDB(B1, 0, 1); PG8_STAGE(PG8_SB(0, 0), b2, voffB);
            PG8_BAR; PG8_WAIT_L(0); PG8_MMA(0, 1, At, B1); PG8_BAR;
            PG8_LDA(At, 0, 1); PG8_STAGE(PG8_SA(0, 0), a2, voffA);
            PG8_BAR; PG8_WAIT_L(0); PG8_MMA(1, 0, At, B0); PG8_BAR; PG8_SCHED;
            PG8_STAGE(PG8_SB(0, 1), b2 + hstepB, voffB);
            PG8_WAIT_V(6); PG8_BAR; PG8_MMA(1, 1, At, B1); PG8_BAR;
            PG8_LDB(B0, 1, 0); PG8_SCHED; PG8_LDA(At, 1, 0); PG8_STAGE(PG8_SA(0, 1), a2 + hstepA, voffA);
            PG8_WAIT_L(8); PG8_BAR; PG8_WAIT_L(0); PG8_MMA(0, 0, At, B0); PG8_BAR; PG8_SCHED;
            PG8_LDB(B1, 1, 1); PG8_STAGE(PG8_SB(1, 0), b3, voffB);
            PG8_BAR; PG8_WAIT_L(0); PG8_MMA(0, 1, At, B1); PG8_BAR;
            PG8_LDA(At, 1, 1); PG8_STAGE(PG8_SA(1, 0), a3, voffA);
            PG8_BAR; PG8_WAIT_L(0); PG8_MMA(1, 0, At, B0); PG8_BAR; PG8_SCHED;
            PG8_STAGE(PG8_SB(1, 1), b3 + hstepB, voffB);
            PG8_WAIT_V(6); PG8_BAR; PG8_MMA(1, 1, At, B1); PG8_BAR;
            }
        }
        if constexpr (ALIGN_EPI) { if (wr == 0) PG8_BAR; }
        if constexpr (!Epi::AFTER_DRAIN) { E(acc, cur, wr, wc, fr, fq); S.done(cur); }
        if (!has_next) break;
#pragma unroll
        for (int a = 0; a < 2; ++a)
#pragma unroll
            for (int b = 0; b < 2; ++b)
#pragma unroll
                for (int m = 0; m < 4; ++m)
#pragma unroll
                    for (int n = 0; n < 2; ++n) acc[a][b][m][n] = (f32x4){0.f, 0.f, 0.f, 0.f};
        cur = nxt; cA = nA; cB = nB; ++ui;
        if constexpr (ALIGN_EPI) { if (wr == 1) PG8_BAR; }
    }
    PG8_WAIT_V(0);
    if constexpr (!ALIGN_EPI) { if (wr == 0) PG8_BAR; }
    PG8_BAR;
#undef PG8_SA
#undef PG8_SB
#undef PG8_STAGE
#undef PG8_LDA
#undef PG8_LDB
#undef PG8_MMA
#undef PG8_WAIT_V
#undef PG8_WAIT_L
#undef PG8_BAR
#undef PG8_SCHED
}
}

#define XB_TMO      128
#define XB_XCNT(j)  (256  + 64 * (j))
#define XB_XSUB(j)  (1280 + 64 * (j))
#define XB_XGEN(j)  (2304 + 64 * (j))
#define XB_TOP      3328
#define XB_TOPGEN   3392
#define XCD_BAR_WORDS 3456
#define XB_SPIN_CAP (1u << 20)
__device__ __forceinline__ unsigned xb_ld(unsigned* p)              { return __hip_atomic_load(p, __ATOMIC_RELAXED, __HIP_MEMORY_SCOPE_AGENT); }
__device__ __forceinline__ unsigned xb_add(unsigned* p, unsigned v) { return __hip_atomic_fetch_add(p, v, __ATOMIC_RELAXED, __HIP_MEMORY_SCOPE_AGENT); }
__device__ __forceinline__ unsigned xb_xcc_id() { return (unsigned)__builtin_amdgcn_s_getreg((3 << 11) | 20) & 0xFu; }
#define XB_SPIN(cond, bar) do { unsigned _sp = 0; while (cond) { __builtin_amdgcn_s_sleep(1); \
    if ((++_sp & 255u) == 0u) { if (xb_ld(&(bar)[XB_TMO])) break; if (_sp > XB_SPIN_CAP) { atomicAdd(&(bar)[XB_TMO], 1u); break; } } } } while (0)
struct XcdBarrier { unsigned* bar; unsigned x; volatile LAS unsigned* st; unsigned G; };
__device__ __forceinline__ XcdBarrier xcd_barrier_post(unsigned* bar, volatile LAS unsigned* st, unsigned G, bool member) {
    XcdBarrier b; b.bar = bar; b.x = xb_xcc_id(); b.st = st; b.G = G;
    if (member && threadIdx.x == 0) (void)xb_add(&bar[XB_XCNT(b.x)], 1u);
    return b;
}
__device__ __forceinline__ void xcd_barrier_complete(unsigned* bar, unsigned x, unsigned& nloc, unsigned& nx, const unsigned G) {
    unsigned sum, cnt, mine, sp = 0u;
    for (;;) {
        sum = 0u; cnt = 0u; mine = 0u;
#pragma unroll
        for (unsigned j = 0; j < 16; ++j) { const unsigned c = xb_ld(&bar[XB_XCNT(j)]); sum += c; cnt += (c > 0u) ? 1u : 0u; mine = (j == x) ? c : mine; }
        if (sum == G) break;
        __builtin_amdgcn_s_sleep(1);
        if ((++sp & 255u) == 0u) { if (xb_ld(&bar[XB_TMO])) break; if (sp > XB_SPIN_CAP) { atomicAdd(&bar[XB_TMO], 1u); break; } }
    }
    nloc = mine > 0u ? mine : 1u; nx = cnt > 0u ? cnt : 1u;
}
__device__ __forceinline__ void xcd_barrier(const XcdBarrier& b) {
    asm volatile("s_waitcnt vmcnt(0)" ::: "memory");
    __syncthreads();
    if (threadIdx.x == 0) {
        unsigned* bar = b.bar;
        __builtin_amdgcn_s_waitcnt(0);
        unsigned nloc = b.st[0], nx = b.st[1];
        if (nloc == 0u) { xcd_barrier_complete(bar, b.x, nloc, nx, b.G); b.st[0] = nloc; b.st[1] = nx; }
        const unsigned old = xb_add(&bar[XB_XSUB(b.x)], 1u);
        const unsigned gen = old / nloc;
        if (old + 1u == (gen + 1u) * nloc) {
            __builtin_amdgcn_fence(__ATOMIC_RELEASE, "agent");
            asm volatile("s_waitcnt vmcnt(0)" ::: "memory");
            const unsigned og = xb_add(&bar[XB_TOP], 1u);
            const unsigned tg = og / nx;
            if (og + 1u == (tg + 1u) * nx) xb_add(&bar[XB_TOPGEN], 1u);
            else XB_SPIN(xb_ld(&bar[XB_TOPGEN]) == tg, bar);
            __builtin_amdgcn_fence(__ATOMIC_ACQUIRE, "agent");
            xb_add(&bar[XB_XGEN(b.x)], 1u);
            asm volatile("s_waitcnt vmcnt(0)" ::: "memory");
        } else {
            XB_SPIN(xb_ld(&bar[XB_XGEN(b.x)]) == gen, bar);
            __builtin_amdgcn_fence(__ATOMIC_ACQUIRE, "agent");
            asm volatile("s_waitcnt vmcnt(0)" ::: "memory");
        }
    }
    __syncthreads();
}

__device__ __forceinline__ void transpose_item(const float* W, int K, int N, bf16* WT, LAS float* scr, int item, int nblk, int lane) {
    const int kb = item / nblk, nb = item % nblk, k0 = 64 * kb, n0 = 32 * nb;
    const int ncol = n0 + (lane & 31); const bool ok = ncol < N;
#pragma unroll 8
    for (int i = 0; i < 32; ++i) { const int kk = 2 * i + (lane >> 5); scr[kk * 33 + (lane & 31)] = ok ? W[(size_t)(k0 + kk) * N + ncol] : 0.f; }
    asm volatile("s_waitcnt lgkmcnt(0)" ::: "memory");
    const int c = lane & 7;
#pragma unroll
    for (int j = 0; j < 4; ++j) { const int n = (lane >> 3) + 8 * j; const LAS float* s = scr + (8 * c) * 33 + n;
        u32x4 o; o.x = pk2(s[0 * 33], s[1 * 33]); o.y = pk2(s[2 * 33], s[3 * 33]); o.z = pk2(s[4 * 33], s[5 * 33]); o.w = pk2(s[6 * 33], s[7 * 33]);
        *(u32x4*)(WT + (size_t)(n0 + n) * K + k0 + 8 * c) = o; }
    asm volatile("s_waitcnt lgkmcnt(0)" ::: "memory");
}
constexpr int WI_IN = 16 * 120, WI_OUT = 16 * 32, WI_1 = 16 * 128, WI_2 = 64 * 32, WI_ALL = WI_IN + WI_OUT + WI_1 + WI_2;
__device__ __forceinline__ void phase_weights(LAS unsigned char* lds, const float* w_in, const float* w_out, const float* w1, const float* w2, unsigned char* wsW, int it_lo, int it_hi, int it_step, int wave, int lane) {
    LAS float* scr = (LAS float*)(lds + wave * 16384);
    constexpr int I_IN = WI_IN, I_OUT = WI_OUT, I_1 = WI_1;
    for (int it = it_lo; it < it_hi; it += it_step) {
        int r = it;
        if (r < I_IN) { transpose_item(w_in, D, INC, (bf16*)(wsW + WOFF_IN), scr, r, 120, lane); continue; } r -= I_IN;
        if (r < I_OUT) { transpose_item(w_out, D, D, (bf16*)(wsW + WOFF_OUT), scr, r, 32, lane); continue; } r -= I_OUT;
        if (r < I_1) { transpose_item(w1, D, FF, (bf16*)(wsW + WOFF_W1), scr, r, 128, lane); continue; } r -= I_1;
        transpose_item(w2, FF, D, (bf16*)(wsW + WOFF_W2), scr, r, 32, lane);
    }
}
__device__ __forceinline__ void phase_mod(LAS unsigned char* lds, const float* c, const float* c_ctx, const float* w_mod, const float* b_mod, float* MOD, int tid, int bid, int G) {
    LAS float* sc = (LAS float*)lds;
    LAS float* red = sc + NMODC * 1024;
    const int wave = tid >> 6, lane = tid & 63;
    if (bid >= 192) return;
    for (int i = tid; i < NMODC * 1024; i += NTHR) { const int ci = i >> 10, k = i & 1023; const float x = ci == 0 ? c_ctx[k] : c[(ci - 1) * 1024 + k]; sc[i] = siluf_(x); }
    __syncthreads();
    for (int task = bid; task < 192; task += G) {
        const int l = task / 96, cg = task % 96, col = cg * 64 + lane;
        float acc[NMODC];
#pragma unroll
        for (int ci = 0; ci < NMODC; ++ci) acc[ci] = 0.f;
        const float* wp = w_mod + ((size_t)l * 1024 + wave * 128) * 6144 + col;
#pragma unroll 4
        for (int k = 0; k < 128; ++k) { const float wv = wp[(size_t)k * 6144];
#pragma unroll
            for (int ci = 0; ci < NMODC; ++ci) acc[ci] += sc[ci * 1024 + wave * 128 + k] * wv; }
#pragma unroll
        for (int ci = 0; ci < NMODC; ++ci) red[(wave * NMODC + ci) * 64 + lane] = acc[ci];
        __syncthreads();
        for (int i = tid; i < NMODC * 64; i += NTHR) { const int ci = i >> 6, ln = i & 63; float s = b_mod[l * 6144 + cg * 64 + ln];
#pragma unroll
            for (int w = 0; w < 8; ++w) s += red[(w * NMODC + ci) * 64 + ln];
            MOD[((size_t)l * NMODC + ci) * 6144 + cg * 64 + ln] = s; }
        __syncthreads();
    }
}
__device__ __forceinline__ void phase_norm(const float* xc, const float* xl, const float* ng, const float* MODl, int sh_off, int sc_off, bf16* XN, int m_lo, int m_hi, int gw, int NGW, int lane) {
    for (int m = m_lo + gw; m < m_hi; m += NGW) {
        const float* xrow = m < MCTX ? xc + (size_t)m * D : xl + (size_t)(m - MCTX) * D;
        const int ci = m < MCTX ? 0 : 1 + ((m - MCTX) >> 11);
        const f32x4* xr = (const f32x4*)xrow + lane;
        f32x4 v[4]; float s = 0.f;
#pragma unroll
        for (int j = 0; j < 4; ++j) { v[j] = xr[64 * j]; s += (v[j].x * v[j].x + v[j].y * v[j].y) + (v[j].z * v[j].z + v[j].w * v[j].w); }
        const float rstd = rsqrtf(wave_sum(s, lane) * (1.f / D) + 1e-6f);
        u32x2* o8 = (u32x2*)(XN + (size_t)m * D) + lane;
#pragma unroll
        for (int j = 0; j < 4; ++j) { const int k = 4 * lane + 256 * j;
            const f32x4 g4 = *(const f32x4*)(ng + k), sc4 = *(const f32x4*)(MODl + ci * 6144 + sc_off + k), sh4 = *(const f32x4*)(MODl + ci * 6144 + sh_off + k);
            const f32x4 o = v[j] * rstd * g4 * (sc4 + 1.0f) + sh4;
            u32x2 w; w.x = pk2(o.x, o.y); w.y = pk2(o.z, o.w); o8[64 * j] = w; }
    }
}
__device__ __forceinline__ void phase_final_norm(float* x, const float* fg, int m_lo, int m_hi, int gw, int NGW, int lane) {
    for (int m = m_lo + gw; m < m_hi; m += NGW) {
        f32x4* xr = (f32x4*)(x + (size_t)m * D) + lane;
        f32x4 v[4]; float s = 0.f;
#pragma unroll
        for (int j = 0; j < 4; ++j) { v[j] = xr[64 * j]; s += (v[j].x * v[j].x + v[j].y * v[j].y) + (v[j].z * v[j].z + v[j].w * v[j].w); }
        const float rstd = rsqrtf(wave_sum(s, lane) * (1.f / D) + 1e-6f);
#pragma unroll
        for (int j = 0; j < 4; ++j) { const f32x4 g4 = *(const f32x4*)(fg + 4 * lane + 256 * j); xr[64 * j] = v[j] * rstd * g4; }
    }
}

__device__ __forceinline__ void shiftmix8(const bf16* zr, int col, bool hasp, bool hasn, const float* mu, float (&o)[8]) {
    float c[8], p[8], n[8], mv[8];
    ld8(zr + col, c);
    if (hasp) ld8(zr - ZP + col, p); else {
#pragma unroll
        for (int j = 0; j < 8; ++j) p[j] = 0.f; }
    if (hasn) ld8(zr + ZP + col, n); else {
#pragma unroll
        for (int j = 0; j < 8; ++j) n[j] = 0.f; }
    ldf8(mu + (col - OFF_C), mv);
#pragma unroll
    for (int j = 0; j < 8; ++j) o[j] = c[j] + mv[j] * (0.5f * (p[j] + n[j]) - c[j]);
}

__device__ __forceinline__ u32x2 pack4bf(const f32x4 v) { u32x2 w; w.x = pk2(v[0], v[1]); w.y = pk2(v[2], v[3]); return w; }
#define MFMA16(a, b, c) __builtin_amdgcn_mfma_f32_16x16x32_bf16(a, b, c, 0, 0, 0)
__device__ __forceinline__ void unit_gmlp(LAS unsigned char* lds, bf16* Z, const float* ln_g, const float* w_s, const float* b_s, int cidx, int g, int tid) {
    constexpr int PW = 136;
    LAS bf16* WsB = (LAS bf16*)lds;
    LAS bf16* VnT = WsB + 128 * PW;
    const int wave = __builtin_amdgcn_readfirstlane(tid >> 6), lane = tid & 63, fr = lane & 15, fq = lane >> 4;
    {
        const float* wg = w_s + (size_t)g * 128 * 128;
#pragma unroll
        for (int it = 0; it < 4; ++it) { const int item = tid + it * NTHR, t = item >> 4, s8 = (item & 15) * 8;
            float a[8]; ldf8(wg + t * 128 + s8, a);
            u32x4 w; w.x = pk2(a[0], a[1]); w.y = pk2(a[2], a[3]); w.z = pk2(a[4], a[5]); w.w = pk2(a[6], a[7]); *(LAS u32x4*)(WsB + t * PW + s8) = w; }
    }
    {
        const int s = tid >> 2, qd = tid & 3;
        const bf16* zrow = Z + (size_t)(cidx * 128 + s) * ZP;
        float x[16];
        { float a[8], b[8]; ld8(zrow + 256 + 64 * g + qd * 16, a); ld8(zrow + 256 + 64 * g + qd * 16 + 8, b);
#pragma unroll
          for (int j = 0; j < 8; ++j) { x[j] = geluf_(a[j]); x[8 + j] = geluf_(b[j]); } }
        float sum = 0.f;
#pragma unroll
        for (int j = 0; j < 16; ++j) sum += x[j];
        sum = sum4(sum);
        const float mean = sum * (1.f / 64.f);
        float sq = 0.f;
#pragma unroll
        for (int j = 0; j < 16; ++j) { x[j] -= mean; sq += x[j] * x[j]; }
        sq = sum4(sq);
        const float rstd = rsqrtf(sq * (1.f / 64.f) + 1e-5f);
        float lga[8], lgb[8]; ldf8(ln_g + 64 * g + qd * 16, lga); ldf8(ln_g + 64 * g + qd * 16 + 8, lgb);
#pragma unroll
        for (int j = 0; j < 8; ++j) { VnT[(qd * 16 + j) * PW + s] = (bf16)f2bf(x[j] * rstd * lga[j]); VnT[(qd * 16 + 8 + j) * PW + s] = (bf16)f2bf(x[8 + j] * rstd * lgb[j]); }
    }
    __syncthreads();
    {
        const int t = 16 * wave + fr;
        bf16x8 bw[4];
#pragma unroll
        for (int ks = 0; ks < 4; ++ks) bw[ks] = *(const LAS bf16x8*)(WsB + t * PW + 32 * ks + 8 * fq);
        bf16* zrow = Z + (size_t)(cidx * 128 + t) * ZP + 64 * g;
        const float bias = b_s[g * 128 + t];
#pragma unroll
        for (int ct = 0; ct < 4; ++ct) {
            f32x4 acc = (f32x4){0.f, 0.f, 0.f, 0.f};
#pragma unroll
            for (int ks = 0; ks < 4; ++ks) acc = MFMA16(*(const LAS bf16x8*)(VnT + (16 * ct + fr) * PW + 32 * ks + 8 * fq), bw[ks], acc);
            const int c = 16 * ct + 4 * fq;
            const u32x2 uu = *(const u32x2*)(zrow + c);
            f32x4 o;
            o[0] = geluf_(__uint_as_float(uu.x << 16)) * (acc[0] + bias); o[1] = geluf_(__uint_as_float(uu.x & 0xffff0000u)) * (acc[1] + bias);
            o[2] = geluf_(__uint_as_float(uu.y << 16)) * (acc[2] + bias); o[3] = geluf_(__uint_as_float(uu.y & 0xffff0000u)) * (acc[3] + bias);
            *(u32x2*)(zrow + c) = pack4bf(o);
        }
    }
    __syncthreads();
}

#define LDS_BARRIER() do { asm volatile("s_waitcnt lgkmcnt(0)" ::: "memory"); __builtin_amdgcn_s_barrier(); asm volatile("" ::: "memory"); } while (0)
#define DPPF(old, x, ctrl, rmask, bc) __uint_as_float(__builtin_amdgcn_update_dpp(__float_as_uint(old), __float_as_uint(x), ctrl, rmask, 0xf, bc))
__device__ __forceinline__ float wave_scan_add(float x) {
    x += DPPF(0.f, x, 0x111, 0xf, true); x += DPPF(0.f, x, 0x112, 0xf, true); x += DPPF(0.f, x, 0x114, 0xf, true); x += DPPF(0.f, x, 0x118, 0xf, true);
    x += DPPF(0.f, x, 0x142, 0xa, true); x += DPPF(0.f, x, 0x143, 0xc, true);
    return x;
}
__device__ __forceinline__ float wave_scan_max(float x) {
    const float ninf = -__builtin_inff();
    x = fmaxf(x, DPPF(ninf, x, 0x111, 0xf, false)); x = fmaxf(x, DPPF(ninf, x, 0x112, 0xf, false)); x = fmaxf(x, DPPF(ninf, x, 0x114, 0xf, false)); x = fmaxf(x, DPPF(ninf, x, 0x118, 0xf, false));
    x = fmaxf(x, DPPF(ninf, x, 0x142, 0xa, false)); x = fmaxf(x, DPPF(ninf, x, 0x143, 0xc, false));
    return x;
}

__device__ __forceinline__ void unit_mlstm(LAS unsigned char* lds, const bf16* Z, bf16* HS, const float* conv, const float* gate_b,
                                           const float* C0, const float* n0, const float* m0, float* Cout, float* nout, float* mout,
                                           int rowbase, int T, int r, int h, int tid) {
    constexpr int P = 72;
    LAS bf16* Qb = (LAS bf16*)lds;
    LAS bf16* Kb = Qb + 64 * P;
    LAS bf16* KwT = Kb + 64 * P;
    LAS bf16* VT = KwT + 64 * P;
    LAS bf16* Sb = VT + 80 * P;
    LAS bf16* CTb = Sb + 64 * P;
    LAS float* e1 = (LAS float*)(CTb + 80 * P);
    LAS float* e2 = e1 + 64;
    LAS float* gin = e2 + 64;
    LAS float* emt = gin + 64;
    const int wave = __builtin_amdgcn_readfirstlane(tid >> 6), lane = tid & 63, fr = lane & 15, fq = lane >> 4;
    const int tau = tid >> 3, oct = tid & 7;
    const int mtC = wave & 3, ntC0 = 2 * (wave >> 2);
    for (int i = tid; i < 16 * P; i += NTHR) { VT[64 * P + i] = (i < P) ? (bf16)0x3F80 : (bf16)0; CTb[64 * P + i] = 0; }
    f32x4 Cacc[3];
#pragma unroll
    for (int t = 0; t < 3; ++t) {
        const int nt = t < 2 ? ntC0 + t : 4, dv = 16 * nt + fr;
#pragma unroll
        for (int i = 0; i < 4; ++i) { const int dk = 16 * mtC + 4 * fq + i; float v = 0.f;
            if (C0) { if (t < 2) v = C0[dk * 64 + dv]; else if (fr == 0) v = n0[dk]; }
            Cacc[t][i] = v; }
    }
    float ms = C0 ? m0[0] : 0.f;
    float cq[3][8], ck[3][8];
#pragma unroll
    for (int i = 0; i < 3; ++i) { ldf8(conv + i * 768 + 64 * h + 8 * oct, cq[i]); ldf8(conv + i * 768 + 384 + 64 * h + 8 * oct, ck[i]); }
    const float gbi = gate_b[r * 12 + h], gbf = gate_b[r * 12 + 6 + h];
    LDS_BARRIER();
#pragma unroll
    for (int t = 0; t < 3; ++t) { const int nt = t < 2 ? ntC0 + t : 4; if (t < 2 || wave < 4) *(LAS u32x2*)(CTb + (16 * nt + fr) * P + 16 * mtC + 4 * fq) = pack4bf(Cacc[t]); }
    const int nch = T / 64;
    const int qcol = OFF_QK + 64 * h + 8 * oct, kcol = OFF_QK + 384 + 64 * h + 8 * oct, vcol = OFF_V + 64 * h + 8 * oct;
    u32x4 rq[3], rk[3], rv; unsigned short rgi, rgf;
    const u32x4 zero4 = (u32x4){0u, 0u, 0u, 0u};
#define ML_LOAD(c) do { const int tq_ = r ? T - 1 - (64 * (c) + tau) : 64 * (c) + tau; const bf16* zr_ = Z + ((size_t)rowbase + tq_) * ZP; \
        rq[1] = *(const u32x4*)(zr_ + qcol); rk[1] = *(const u32x4*)(zr_ + kcol); rv = *(const u32x4*)(zr_ + vcol); \
        rq[0] = tq_ > 0 ? *(const u32x4*)(zr_ - ZP + qcol) : zero4; rk[0] = tq_ > 0 ? *(const u32x4*)(zr_ - ZP + kcol) : zero4; \
        rq[2] = tq_ < T - 1 ? *(const u32x4*)(zr_ + ZP + qcol) : zero4; rk[2] = tq_ < T - 1 ? *(const u32x4*)(zr_ + ZP + kcol) : zero4; \
        const int tl_ = r ? T - 1 - (64 * (c) + lane) : 64 * (c) + lane; const bf16* zg_ = Z + ((size_t)rowbase + tl_) * ZP + OFF_G + 12 * r; rgi = zg_[h]; rgf = zg_[6 + h]; } while (0)
    ML_LOAD(0);
#pragma unroll 1
    for (int ci = 0; ci < nch; ++ci) {
        const float gil = bf2f(rgi) + gbi;
        const float bcs = wave_scan_add(logsigf_(bf2f(rgf) + gbf));
        const float pmx = wave_scan_max(gil - bcs);
        const float mt = bcs + fmaxf(ms, pmx);
        const float b63 = __uint_as_float(__builtin_amdgcn_readlane(__float_as_uint(bcs), 63)), mnew = __uint_as_float(__builtin_amdgcn_readlane(__float_as_uint(mt), 63));
        const float ginl = __expf(bcs + ms - mt);
        const float wendl = __expf(b63 - bcs + gil - mnew);
        const float cd = __expf(b63 + ms - mnew);
        ms = mnew;
        if (wave == 0) { e1[lane] = bcs - mt; e2[lane] = gil - bcs; gin[lane] = ginl; emt[lane] = __expf(-mt); }
        const float wend_t = bperm(wendl, 8 * (wave & 7) + (lane >> 3));
        {
            float c[8], p[8], n[8];
            { const u32x4 w = rq[1]; c[0] = __uint_as_float(w.x << 16); c[1] = __uint_as_float(w.x & 0xffff0000u); c[2] = __uint_as_float(w.y << 16); c[3] = __uint_as_float(w.y & 0xffff0000u); c[4] = __uint_as_float(w.z << 16); c[5] = __uint_as_float(w.z & 0xffff0000u); c[6] = __uint_as_float(w.w << 16); c[7] = __uint_as_float(w.w & 0xffff0000u); }
            { const u32x4 w = rq[0]; p[0] = __uint_as_float(w.x << 16); p[1] = __uint_as_float(w.x & 0xffff0000u); p[2] = __uint_as_float(w.y << 16); p[3] = __uint_as_float(w.y & 0xffff0000u); p[4] = __uint_as_float(w.z << 16); p[5] = __uint_as_float(w.z & 0xffff0000u); p[6] = __uint_as_float(w.w << 16); p[7] = __uint_as_float(w.w & 0xffff0000u); }
            { const u32x4 w = rq[2]; n[0] = __uint_as_float(w.x << 16); n[1] = __uint_as_float(w.x & 0xffff0000u); n[2] = __uint_as_float(w.y << 16); n[3] = __uint_as_float(w.y & 0xffff0000u); n[4] = __uint_as_float(w.z << 16); n[5] = __uint_as_float(w.z & 0xffff0000u); n[6] = __uint_as_float(w.w << 16); n[7] = __uint_as_float(w.w & 0xffff0000u); }
#pragma unroll
            for (int j = 0; j < 8; ++j) c[j] = siluf_(p[j] * cq[0][j] + c[j] * cq[1][j] + n[j] * cq[2][j]);
            { u32x4 w; w.x = pk2(c[0], c[1]); w.y = pk2(c[2], c[3]); w.z = pk2(c[4], c[5]); w.w = pk2(c[6], c[7]); *(LAS u32x4*)(Qb + tau * P + 8 * oct) = w; }
            { const u32x4 w = rk[1]; c[0] = __uint_as_float(w.x << 16); c[1] = __uint_as_float(w.x & 0xffff0000u); c[2] = __uint_as_float(w.y << 16); c[3] = __uint_as_float(w.y & 0xffff0000u); c[4] = __uint_as_float(w.z << 16); c[5] = __uint_as_float(w.z & 0xffff0000u); c[6] = __uint_as_float(w.w << 16); c[7] = __uint_as_float(w.w & 0xffff0000u); }
            { const u32x4 w = rk[0]; p[0] = __uint_as_float(w.x << 16); p[1] = __uint_as_float(w.x & 0xffff0000u); p[2] = __uint_as_float(w.y << 16); p[3] = __uint_as_float(w.y & 0xffff0000u); p[4] = __uint_as_float(w.z << 16); p[5] = __uint_as_float(w.z & 0xffff0000u); p[6] = __uint_as_float(w.w << 16); p[7] = __uint_as_float(w.w & 0xffff0000u); }
            { const u32x4 w = rk[2]; n[0] = __uint_as_float(w.x << 16); n[1] = __uint_as_float(w.x & 0xffff0000u); n[2] = __uint_as_float(w.y << 16); n[3] = __uint_as_float(w.y & 0xffff0000u); n[4] = __uint_as_float(w.z << 16); n[5] = __uint_as_float(w.z & 0xffff0000u); n[6] = __uint_as_float(w.w << 16); n[7] = __uint_as_float(w.w & 0xffff0000u); }
#pragma unroll
            for (int j = 0; j < 8; ++j) c[j] = 0.125f * siluf_(p[j] * ck[0][j] + c[j] * ck[1][j] + n[j] * ck[2][j]);
            { u32x4 w; w.x = pk2(c[0], c[1]); w.y = pk2(c[2], c[3]); w.z = pk2(c[4], c[5]); w.w = pk2(c[6], c[7]); *(LAS u32x4*)(Kb + tau * P + 8 * oct) = w; }
#pragma unroll
            for (int j = 0; j < 8; ++j) KwT[(8 * oct + j) * P + tau] = (bf16)f2bf(c[j] * wend_t);
            const unsigned vw[4] = {rv.x, rv.y, rv.z, rv.w};
#pragma unroll
            for (int j = 0; j < 4; ++j) { VT[(8 * oct + 2 * j) * P + tau] = (bf16)(vw[j] & 0xffffu); VT[(8 * oct + 2 * j + 1) * P + tau] = (bf16)(vw[j] >> 16); }
        }
        if (ci + 1 < nch) ML_LOAD(ci + 1);
        LDS_BARRIER();
        const int ntT = wave & 3, mt0 = 2 * (wave >> 2);
        f32x4 qc[3];
        {
            bf16x8 bq[2];
#pragma unroll
            for (int ks = 0; ks < 2; ++ks) bq[ks] = *(const LAS bf16x8*)(Qb + (16 * ntT + fr) * P + 32 * ks + 8 * fq);
            const float e1t = e1[16 * ntT + fr];
#pragma unroll
            for (int t = 0; t < 2; ++t) {
                const int mt_ = mt0 + t;
                f32x4 a = (f32x4){0.f, 0.f, 0.f, 0.f};
#pragma unroll
                for (int ks = 0; ks < 2; ++ks) a = MFMA16(*(const LAS bf16x8*)(Kb + (16 * mt_ + fr) * P + 32 * ks + 8 * fq), bq[ks], a);
                const f32x4 e2v = *(const LAS f32x4*)(e2 + 16 * mt_ + 4 * fq);
#pragma unroll
                for (int i = 0; i < 4; ++i) { const int sg = 16 * mt_ + 4 * fq + i; a[i] = sg <= 16 * ntT + fr ? a[i] * __expf(e1t + e2v[i]) : 0.f; }
                *(LAS u32x2*)(Sb + (16 * ntT + fr) * P + 16 * mt_ + 4 * fq) = pack4bf(a);
            }
#pragma unroll
            for (int t = 0; t < 3; ++t) {
                const int mt_ = t < 2 ? mt0 + t : 4;
                f32x4 a = (f32x4){0.f, 0.f, 0.f, 0.f};
#pragma unroll
                for (int ks = 0; ks < 2; ++ks) a = MFMA16(*(const LAS bf16x8*)(CTb + (16 * mt_ + fr) * P + 32 * ks + 8 * fq), bq[ks], a);
                qc[t] = a;
            }
        }
        LDS_BARRIER();
        {
            bf16x8 bs[2];
#pragma unroll
            for (int ks = 0; ks < 2; ++ks) bs[ks] = *(const LAS bf16x8*)(Sb + (16 * ntT + fr) * P + 32 * ks + 8 * fq);
            f32x4 sv[3];
#pragma unroll
            for (int t = 0; t < 3; ++t) {
                const int mt_ = t < 2 ? mt0 + t : 4;
                f32x4 a = (f32x4){0.f, 0.f, 0.f, 0.f};
#pragma unroll
                for (int ks = 0; ks < 2; ++ks) a = MFMA16(*(const LAS bf16x8*)(VT + (16 * mt_ + fr) * P + 32 * ks + 8 * fq), bs[ks], a);
                sv[t] = a;
            }
            const int tt = 16 * ntT + fr;
            const float gt = gin[tt];
            const float den = bperm(sv[2][0], fr) + gt * bperm(qc[2][0], fr);
            const float inv = 1.0f / fmaxf(fabsf(den), emt[tt]);
            const int tq = r ? T - 1 - (64 * ci + tt) : 64 * ci + tt;
            bf16* hrow = HS + ((size_t)r * M + rowbase + tq) * 384 + 64 * h;
#pragma unroll
            for (int t = 0; t < 2; ++t) { const f32x4 o = (sv[t] + gt * qc[t]) * inv; *(u32x2*)(hrow + 16 * (mt0 + t) + 4 * fq) = pack4bf(o); }
            bf16x8 ak[2];
#pragma unroll
            for (int ks = 0; ks < 2; ++ks) ak[ks] = *(const LAS bf16x8*)(KwT + (16 * mtC + fr) * P + 32 * ks + 8 * fq);
#pragma unroll
            for (int t = 0; t < 3; ++t) {
                const int nt = t < 2 ? ntC0 + t : 4;
                f32x4 a = Cacc[t] * cd;
#pragma unroll
                for (int ks = 0; ks < 2; ++ks) a = MFMA16(ak[ks], *(const LAS bf16x8*)(VT + (16 * nt + fr) * P + 32 * ks + 8 * fq), a);
                Cacc[t] = a;
            }
        }
        LDS_BARRIER();
#pragma unroll
        for (int t = 0; t < 3; ++t) { const int nt = t < 2 ? ntC0 + t : 4; if (t < 2 || wave < 4) *(LAS u32x2*)(CTb + (16 * nt + fr) * P + 16 * mtC + 4 * fq) = pack4bf(Cacc[t]); }
    }
#undef ML_LOAD
    if (Cout) {
#pragma unroll
        for (int t = 0; t < 2; ++t)
#pragma unroll
            for (int i = 0; i < 4; ++i) Cout[(16 * mtC + 4 * fq + i) * 64 + 16 * (ntC0 + t) + fr] = Cacc[t][i];
        if (wave < 4 && fr == 0) {
#pragma unroll
            for (int i = 0; i < 4; ++i) nout[16 * mtC + 4 * fq + i] = Cacc[2][i]; }
        if (tid == 0) mout[0] = ms;
    }
    LDS_BARRIER();
}

__device__ __forceinline__ void unit_rwkv(LAS unsigned char* lds, const bf16* Z, bf16* YS, float* BON, const float* mu, const float* w0, const float* w2, const float* a0, const float* a2,
                                          const float* k_k, const float* k_a, const float* r_k, const float* S0, float* Sout_base, int sout_idx, int rowbase, int T, int r, int h, int tid) {
    constexpr int P = 72, IMG = 64 * P, PL = 68, PD = 24;
    LAS bf16* img = (LAS bf16*)lds;
    LAS bf16 *W2T = img, *A2T = img + IMG, *At = img + 2 * IMG, *Rt = img + 3 * IMG, *Btk = img + 4 * IMG, *Ktk = img + 5 * IMG, *Bkj = img + 6 * IMG, *Kkj = img + 7 * IMG,
             *Vvj = img + 8 * IMG, *Svk = img + 9 * IMG, *MkT = img + 10 * IMG, *NbT = img + 11 * IMG, *NkT = img + 12 * IMG, *TT = img + 13 * IMG, *Mbj = img + 14 * IMG;
    LAS bf16 *Xvt = Btk, *Uvj = Ktk, *DWb = MkT, *DAb = NbT;
    LAS float* LD = (LAS float*)(img + 12 * IMG);
    LAS float* LW = LD + 64 * PL;
    LAS bf16* AA = (LAS bf16*)(LW + 64 * PL);
    LAS float* MD = (LAS float*)(img + 15 * IMG);
    LAS bf16* TD = (LAS bf16*)(MD + 1024);
    LAS bf16* PTs = TD + 64 * PD;
    LAS float* DL = (LAS float*)((LAS unsigned char*)lds + 154624);
    LAS float* CST = DL + 64;
    const int wave = __builtin_amdgcn_readfirstlane(tid >> 6), lane = tid & 63, fr = lane & 15, fq = lane >> 4;
    const int tau = tid >> 3, oct = tid & 7;
    const int ntW = wave & 3, mt0 = 2 * (wave >> 2);
    const bf16x8 zf = (bf16x8){0, 0, 0, 0, 0, 0, 0, 0};
#define FR(im, row, ks) (*(const LAS bf16x8*)((im) + (row) * P + 32 * (ks) + 8 * fq))
    for (int i = tid; i < 640; i += NTHR) { const int g = i >> 6, c = i & 63; float v;
        if (g == 0) v = mu[64 * h + c]; else if (g == 1) v = mu[384 + 64 * h + c]; else if (g == 2) v = mu[768 + 64 * h + c]; else if (g == 3) v = mu[1152 + 64 * r + c]; else if (g == 4) v = mu[1280 + 64 * r + c];
        else if (g == 5) v = k_k[64 * h + c]; else if (g == 6) v = k_a[64 * h + c]; else if (g == 7) v = r_k[64 * h + c]; else if (g == 8) v = w0[r * 384 + 64 * h + c]; else v = a0[r * 384 + 64 * h + c];
        CST[i] = v; }
    {
        float a[8], b[8];
#pragma unroll
        for (int j = 0; j < 8; ++j) { a[j] = w2[((size_t)r * 64 + 8 * oct + j) * 384 + 64 * h + tau]; b[j] = a2[((size_t)r * 64 + 8 * oct + j) * 384 + 64 * h + tau]; }
        u32x4 w; w.x = pk2(a[0], a[1]); w.y = pk2(a[2], a[3]); w.z = pk2(a[4], a[5]); w.w = pk2(a[6], a[7]); *(LAS u32x4*)(W2T + tau * P + 8 * oct) = w;
        w.x = pk2(b[0], b[1]); w.y = pk2(b[2], b[3]); w.z = pk2(b[4], b[5]); w.w = pk2(b[6], b[7]); *(LAS u32x4*)(A2T + tau * P + 8 * oct) = w;
    }
    f32x4 Sacc[2];
#pragma unroll
    for (int t = 0; t < 2; ++t) { Sacc[t] = S0 ? *(const f32x4*)(S0 + (16 * ntW + fr) * 64 + 16 * (mt0 + t) + 4 * fq) : (f32x4){0.f, 0.f, 0.f, 0.f};
        *(LAS u32x2*)(Svk + (16 * ntW + fr) * P + 16 * (mt0 + t) + 4 * fq) = pack4bf(Sacc[t]); }
    const int nch = T / 64;
    const int c_r = OFF_C + 64 * h + 8 * oct, c_k = OFF_C + 384 + 64 * h + 8 * oct, c_v = OFF_C + 768 + 64 * h + 8 * oct, c_w = OFF_C + 1152 + 64 * r + 8 * oct, c_a = OFF_C + 1280 + 64 * r + 8 * oct;
    u32x4 raw[5][3];
#define RW_LOAD(c) do { unsigned zq_; asm volatile("v_mov_b32 %0, 0" : "=v"(zq_)); const u32x4 zero4 = (u32x4){zq_, zq_, zq_, zq_}; const int tau = tid >> 3; const int tq_ = r ? T - 1 - (64 * (c) + tau) : 64 * (c) + tau; const bf16* zr_ = Z + ((size_t)rowbase + tq_) * ZP; const bool hp_ = tq_ > 0, hn_ = tq_ < T - 1; \
        const int cols_[5] = {c_r, c_k, c_v, c_w, c_a}; \
        _Pragma("unroll") for (int g_ = 0; g_ < 5; ++g_) { raw[g_][1] = *(const u32x4*)(zr_ + cols_[g_]); raw[g_][0] = hp_ ? *(const u32x4*)(zr_ - ZP + cols_[g_]) : zero4; raw[g_][2] = hn_ ? *(const u32x4*)(zr_ + ZP + cols_[g_]) : zero4; } } while (0)
#define UNPK(q_, o) do { const u32x4 q4_ = (q_); o[0] = __uint_as_float(q4_.x << 16); o[1] = __uint_as_float(q4_.x & 0xffff0000u); o[2] = __uint_as_float(q4_.y << 16); o[3] = __uint_as_float(q4_.y & 0xffff0000u); \
        o[4] = __uint_as_float(q4_.z << 16); o[5] = __uint_as_float(q4_.z & 0xffff0000u); o[6] = __uint_as_float(q4_.w << 16); o[7] = __uint_as_float(q4_.w & 0xffff0000u); } while (0)
#define MIX8(g, col, o) do { float c_[8], p_[8], n_[8], m_[8]; UNPK(raw[g][1], c_); UNPK(raw[g][0], p_); UNPK(raw[g][2], n_); { const f32x4 m0_ = *(const LAS f32x4*)(CST + 64 * (g) + 8 * oct), m1_ = *(const LAS f32x4*)(CST + 64 * (g) + 8 * oct + 4); m_[0] = m0_.x; m_[1] = m0_.y; m_[2] = m0_.z; m_[3] = m0_.w; m_[4] = m1_.x; m_[5] = m1_.y; m_[6] = m1_.z; m_[7] = m1_.w; } \
        _Pragma("unroll") for (int j_ = 0; j_ < 8; ++j_) o[j_] = c_[j_] + m_[j_] * (0.5f * (p_[j_] + n_[j_]) - c_[j_]); } while (0)
    RW_LOAD(0);
    LDS_BARRIER();
#pragma unroll 1
    for (int ci = 0; ci < nch; ++ci) {
        float rp[8], kp[8], kk[8];
        {
            int tl_ = tid; asm volatile("" : "+v"(tl_)); const int lane = tl_ & 63, fr = lane & 15, fq = lane >> 4, tau = tl_ >> 3, oct = tl_ & 7; (void)lane; (void)fr; (void)fq; (void)tau; (void)oct;
            float x[8];
            MIX8(0, c_r, rp); MIX8(1, c_k, kp);
            MIX8(2, c_v, x);
#pragma unroll
            for (int j = 0; j < 8; ++j) Vvj[(8 * oct + j) * P + tau] = (bf16)f2bf(x[j]);
            float kkv[8]; { const f32x4 m0_ = *(const LAS f32x4*)(CST + 320 + 8 * oct), m1_ = *(const LAS f32x4*)(CST + 320 + 8 * oct + 4); kkv[0] = m0_.x; kkv[1] = m0_.y; kkv[2] = m0_.z; kkv[3] = m0_.w; kkv[4] = m1_.x; kkv[5] = m1_.y; kkv[6] = m1_.z; kkv[7] = m1_.w; }
            float ss = 0.f;
#pragma unroll
            for (int j = 0; j < 8; ++j) { kkv[j] *= kp[j]; ss += kkv[j] * kkv[j]; }
            ss = sum8(ss);
            const float inv = 1.0f / fmaxf(sqrtf(ss), 1e-12f);
#pragma unroll
            for (int j = 0; j < 8; ++j) kk[j] = kkv[j] * inv;
            MIX8(3, c_w, x);
            { u32x4 w; w.x = pk2(tanhf_(x[0]), tanhf_(x[1])); w.y = pk2(tanhf_(x[2]), tanhf_(x[3])); w.z = pk2(tanhf_(x[4]), tanhf_(x[5])); w.w = pk2(tanhf_(x[6]), tanhf_(x[7])); *(LAS u32x4*)(DWb + tau * P + 8 * oct) = w; }
            MIX8(4, c_a, x);
            { u32x4 w; w.x = pk2(x[0], x[1]); w.y = pk2(x[2], x[3]); w.z = pk2(x[4], x[5]); w.w = pk2(x[6], x[7]); *(LAS u32x4*)(DAb + tau * P + 8 * oct) = w; }
        }
        LDS_BARRIER();
        {
            int tl_ = tid; asm volatile("" : "+v"(tl_)); const int lane = tl_ & 63, fr = lane & 15, fq = lane >> 4, tau = tl_ >> 3, oct = tl_ & 7; (void)lane; (void)fr; (void)fq; (void)tau; (void)oct;
            const int mt = wave & 3, th = wave >> 2;
            bf16x8 afw[2], afa[2];
#pragma unroll
            for (int ks = 0; ks < 2; ++ks) { afw[ks] = FR(W2T, 16 * mt + fr, ks); afa[ks] = FR(A2T, 16 * mt + fr, ks); }
            const f32x4 w0v = *(const LAS f32x4*)(CST + 512 + 16 * mt + 4 * fq), a0v = *(const LAS f32x4*)(CST + 576 + 16 * mt + 4 * fq);
            f32x4 carry = (f32x4){0.f, 0.f, 0.f, 0.f};
#pragma unroll
            for (int nt = 0; nt < 4; ++nt) {
                if (nt == 2 * th || nt == 2 * th + 1) {
                    f32x4 acc = (f32x4){0.f, 0.f, 0.f, 0.f};
#pragma unroll
                    for (int ks = 0; ks < 2; ++ks) acc = MFMA16(afw[ks], FR(DWb, 16 * nt + fr, ks), acc);
                    f32x4 lw, sc;
#pragma unroll
                    for (int i = 0; i < 4; ++i) { lw[i] = -__expf(logsigf_(acc[i] + w0v[i]) - 0.5f); float x = lw[i];
                        x += DPPF(0.f, x, 0x111, 0xf, true); x += DPPF(0.f, x, 0x112, 0xf, true); x += DPPF(0.f, x, 0x114, 0xf, true); x += DPPF(0.f, x, 0x118, 0xf, true);
                        sc[i] = x; }
                    {
                        const f32x4 ld = carry + sc;
                        *(LAS f32x4*)(LD + (16 * nt + fr) * PL + 16 * mt + 4 * fq) = ld; *(LAS f32x4*)(LW + (16 * nt + fr) * PL + 16 * mt + 4 * fq) = lw;
                        f32x4 ua = (f32x4){0.f, 0.f, 0.f, 0.f};
#pragma unroll
                        for (int ks = 0; ks < 2; ++ks) ua = MFMA16(afa[ks], FR(DAb, 16 * nt + fr, ks), ua);
#pragma unroll
                        for (int i = 0; i < 4; ++i) ua[i] = sigmoidf_(ua[i] + a0v[i]);
                        *(LAS u32x2*)(AA + (16 * nt + fr) * P + 16 * mt + 4 * fq) = pack4bf(ua);
                    }
#pragma unroll
                    for (int i = 0; i < 4; ++i) carry[i] += bperm(sc[i], (lane & 48) | 15);
                }
            }
        }
        LDS_BARRIER();
        {
            int tl_ = tid; asm volatile("" : "+v"(tl_)); const int lane = tl_ & 63, fr = lane & 15, fq = lane >> 4, tau = tl_ >> 3, oct = tl_ & 7; (void)lane; (void)fr; (void)fq; (void)tau; (void)oct;
            float ld[8], lw[8], a[8];
            { const f32x4 x0 = *(const LAS f32x4*)(LD + tau * PL + 8 * oct), x1 = *(const LAS f32x4*)(LD + tau * PL + 8 * oct + 4); ld[0] = x0.x; ld[1] = x0.y; ld[2] = x0.z; ld[3] = x0.w; ld[4] = x1.x; ld[5] = x1.y; ld[6] = x1.z; ld[7] = x1.w; }
            { const f32x4 x0 = *(const LAS f32x4*)(LW + tau * PL + 8 * oct), x1 = *(const LAS f32x4*)(LW + tau * PL + 8 * oct + 4); lw[0] = x0.x; lw[1] = x0.y; lw[2] = x0.z; lw[3] = x0.w; lw[4] = x1.x; lw[5] = x1.y; lw[6] = x1.z; lw[7] = x1.w; }
            { const u32x4 w = *(const LAS u32x4*)(AA + tau * P + 8 * oct); UNPK(w, a); }
            if (tau >= 32) { const f32x4 x0 = *(const LAS f32x4*)(LD + 31 * PL + 8 * oct), x1 = *(const LAS f32x4*)(LD + 31 * PL + 8 * oct + 4);
                ld[0] += x0.x; ld[1] += x0.y; ld[2] += x0.z; ld[3] += x0.w; ld[4] += x1.x; ld[5] += x1.y; ld[6] += x1.z; ld[7] += x1.w; }
            float kav[8], rkv[8];
            { const f32x4 m0_ = *(const LAS f32x4*)(CST + 384 + 8 * oct), m1_ = *(const LAS f32x4*)(CST + 384 + 8 * oct + 4); kav[0] = m0_.x; kav[1] = m0_.y; kav[2] = m0_.z; kav[3] = m0_.w; kav[4] = m1_.x; kav[5] = m1_.y; kav[6] = m1_.z; kav[7] = m1_.w; }
            { const f32x4 m0_ = *(const LAS f32x4*)(CST + 448 + 8 * oct), m1_ = *(const LAS f32x4*)(CST + 448 + 8 * oct + 4); rkv[0] = m0_.x; rkv[1] = m0_.y; rkv[2] = m0_.z; rkv[3] = m0_.w; rkv[4] = m1_.x; rkv[5] = m1_.y; rkv[6] = m1_.z; rkv[7] = m1_.w; }
            float at[8], rt[8], bt[8], kt[8]; float bon = 0.f;
#pragma unroll
            for (int j = 0; j < 8; ++j) {
                const float dinc = __expf(ld[j]), dinv = __builtin_amdgcn_rcpf(dinc), dexc = dinc * __expf(-lw[j]);
                const float kd = kp[j] * (1.0f + (a[j] - 1.0f) * kav[j]);
                at[j] = -kk[j] * dexc; rt[j] = rp[j] * dinc; bt[j] = kk[j] * a[j] * dinv; kt[j] = kd * dinv;
                bon += rp[j] * kd * rkv[j];
                if (tau == 63) DL[8 * oct + j] = dinc;
            }
            { u32x4 w; w.x = pk2(at[0], at[1]); w.y = pk2(at[2], at[3]); w.z = pk2(at[4], at[5]); w.w = pk2(at[6], at[7]); *(LAS u32x4*)(At + tau * P + 8 * oct) = w; }
            { u32x4 w; w.x = pk2(rt[0], rt[1]); w.y = pk2(rt[2], rt[3]); w.z = pk2(rt[4], rt[5]); w.w = pk2(rt[6], rt[7]); *(LAS u32x4*)(Rt + tau * P + 8 * oct) = w; }
            { u32x4 w; w.x = pk2(bt[0], bt[1]); w.y = pk2(bt[2], bt[3]); w.z = pk2(bt[4], bt[5]); w.w = pk2(bt[6], bt[7]); *(LAS u32x4*)(Btk + tau * P + 8 * oct) = w; }
            { u32x4 w; w.x = pk2(kt[0], kt[1]); w.y = pk2(kt[2], kt[3]); w.z = pk2(kt[4], kt[5]); w.w = pk2(kt[6], kt[7]); *(LAS u32x4*)(Ktk + tau * P + 8 * oct) = w; }
#pragma unroll
            for (int j = 0; j < 8; ++j) { Bkj[(8 * oct + j) * P + tau] = (bf16)f2bf(bt[j]); Kkj[(8 * oct + j) * P + tau] = (bf16)f2bf(kt[j]); }
            bon = sum8(bon);
            if (oct == 0) { const int tq = r ? T - 1 - (64 * ci + tau) : 64 * ci + tau; BON[((size_t)r * M + rowbase + tq) * 8 + h] = bon; }
        }
        LDS_BARRIER();
        {
            int tl_ = tid; asm volatile("" : "+v"(tl_)); const int lane = tl_ & 63, fr = lane & 15, fq = lane >> 4, tau = tl_ >> 3, oct = tl_ & 7; (void)lane; (void)fr; (void)fq; (void)tau; (void)oct;
            const int tcol = 16 * ntW + fr;
            if (wave == 4 || wave == 5) {
                unsigned zz_; asm volatile("v_mov_b32 %0, 0" : "=v"(zz_)); const u32x2 z2 = (u32x2){zz_, zz_};
#pragma unroll
                for (int t = 0; t < 2; ++t) { const int o = tcol * P + 16 * (2 + t) + 4 * fq; *(LAS u32x2*)(MkT + o) = z2; *(LAS u32x2*)(NbT + o) = z2; *(LAS u32x2*)(NkT + o) = z2; *(LAS u32x2*)(Mbj + o) = z2; }
                const int a0 = 2 * (wave - 4);
#pragma unroll
                for (int t = 0; t < 2; ++t) { const int ab = a0 + t;
                    f32x4 mb = (f32x4){0.f, 0.f, 0.f, 0.f};
#pragma unroll
                    for (int ks = 0; ks < 2; ++ks) mb = MFMA16(FR(Btk, 16 * ab + fr, ks), FR(At, 16 * ab + fr, ks), mb);
#pragma unroll
                    for (int i = 0; i < 4; ++i) MD[(ab * 16 + 4 * fq + i) * 16 + fr] = (4 * fq + i < fr) ? mb[i] : 0.f; }
                asm volatile("s_waitcnt lgkmcnt(0)" ::: "memory");
                const int a = a0 + (fq >> 1), n = fr;
                float x[16];
#pragma unroll
                for (int i = 0; i < 16; ++i) x[i] = (i == n) ? 1.f : 0.f;
#pragma unroll
                for (int i = 14; i >= 0; --i) {
                    float m[16];
#pragma unroll
                    for (int q = 0; q < 4; ++q) { if (4 * q + 3 > i) { const f32x4 v4 = *(const LAS f32x4*)(MD + (a * 16 + i) * 16 + 4 * q); m[4 * q] = v4.x; m[4 * q + 1] = v4.y; m[4 * q + 2] = v4.z; m[4 * q + 3] = v4.w; } else { m[4 * q] = 0.f; m[4 * q + 1] = 0.f; m[4 * q + 2] = 0.f; m[4 * q + 3] = 0.f; } }
                    float s0 = (i == n) ? 1.f : 0.f;
#pragma unroll
                    for (int j = i + 1; j < 16; ++j) s0 += m[j] * x[j];
                    x[i] = s0;
                    asm volatile("" ::: "memory");
                }
                u32x4 w0_, w1_; w0_.x = pk2(x[0], x[1]); w0_.y = pk2(x[2], x[3]); w0_.z = pk2(x[4], x[5]); w0_.w = pk2(x[6], x[7]); w1_.x = pk2(x[8], x[9]); w1_.y = pk2(x[10], x[11]); w1_.z = pk2(x[12], x[13]); w1_.w = pk2(x[14], x[15]);
                if ((fq & 1) == 0) { *(LAS u32x4*)(TT + (16 * a + n) * P + 16 * a) = w0_; *(LAS u32x4*)(TT + (16 * a + n) * P + 16 * a + 8) = w1_; }
            } else {
                bf16x8 bA[2], bR[2];
#pragma unroll
                for (int ks = 0; ks < 2; ++ks) { bA[ks] = FR(At, 16 * ntW + fr, ks); bR[ks] = FR(Rt, 16 * ntW + fr, ks); }
#pragma unroll
                for (int t = 0; t < 2; ++t) {
                    const int mt = mt0 + t;
                    const int o = tcol * P + 16 * mt + 4 * fq;
                    if (mt > ntW) {
                        unsigned zz_; asm volatile("v_mov_b32 %0, 0" : "=v"(zz_)); const u32x2 z2 = (u32x2){zz_, zz_};
                        *(LAS u32x2*)(MkT + o) = z2; *(LAS u32x2*)(NbT + o) = z2; *(LAS u32x2*)(NkT + o) = z2; *(LAS u32x2*)(Mbj + o) = z2;
                    } else {
                        bf16x8 aB[2], aK[2];
#pragma unroll
                        for (int ks = 0; ks < 2; ++ks) { aB[ks] = FR(Btk, 16 * mt + fr, ks); aK[ks] = FR(Ktk, 16 * mt + fr, ks); }
                        f32x4 mk = (f32x4){0.f, 0.f, 0.f, 0.f}, nb = mk, nk = mk, mb = mk;
#pragma unroll
                        for (int ks = 0; ks < 2; ++ks) { mk = MFMA16(aK[ks], bA[ks], mk); nb = MFMA16(aB[ks], bR[ks], nb); nk = MFMA16(aK[ks], bR[ks], nk); mb = MFMA16(aB[ks], bA[ks], mb); }
                        if (mt == ntW) {
#pragma unroll
                            for (int i = 0; i < 4; ++i) { const int jl = 4 * fq + i; if (!(jl < fr)) { mk[i] = 0.f; mb[i] = 0.f; } if (!(jl <= fr)) { nb[i] = 0.f; nk[i] = 0.f; } } }
                        *(LAS u32x2*)(MkT + o) = pack4bf(mk); *(LAS u32x2*)(NbT + o) = pack4bf(nb); *(LAS u32x2*)(NkT + o) = pack4bf(nk); *(LAS u32x2*)(Mbj + o) = pack4bf(mb);
                    }
                }
            }
        }
        LDS_BARRIER();
        if (ci + 1 < nch) RW_LOAD(ci + 1);
        f32x4 y0[2];
        {
            int tl_ = tid; asm volatile("" : "+v"(tl_)); const int lane = tl_ & 63, fr = lane & 15, fq = lane >> 4, tau = tl_ >> 3, oct = tl_ & 7; (void)lane; (void)fr; (void)fq; (void)tau; (void)oct;
            bf16x8 bS[2], bV[2];
#pragma unroll
            for (int ks = 0; ks < 2; ++ks) { bS[ks] = FR(Svk, 16 * ntW + fr, ks); bV[ks] = FR(Vvj, 16 * ntW + fr, ks); }
            f32x4 xa[4];
#pragma unroll
            for (int bb = 0; bb < 4; ++bb) { xa[bb] = (f32x4){0.f, 0.f, 0.f, 0.f};
#pragma unroll
                for (int ks = 0; ks < 2; ++ks) { xa[bb] = MFMA16(FR(At, 16 * bb + fr, ks), bS[ks], xa[bb]); xa[bb] = MFMA16(FR(MkT, 16 * bb + fr, ks), bV[ks], xa[bb]); } }
            u32x2 up[4];
#pragma unroll
            for (int bb = 0; bb < 4; ++bb) {
                f32x4 w = xa[bb];
#pragma unroll
                for (int c = 0; c < 4; ++c) if (c < bb) {
                    const u32x2 am = *(const LAS u32x2*)(Mbj + (16 * bb + fr) * P + 16 * c + 4 * fq);
                    w = MFMA16(__builtin_bit_cast(bf16x8, ((u32x4){am.x, am.y, 0u, 0u})), __builtin_bit_cast(bf16x8, ((u32x4){up[c].x, up[c].y, 0u, 0u})), w);
                }
                const u32x2 wp = pack4bf(w);
                const u32x2 at = *(const LAS u32x2*)(TT + (16 * bb + fr) * P + 16 * bb + 4 * fq);
                const f32x4 ub = MFMA16(__builtin_bit_cast(bf16x8, ((u32x4){at.x, at.y, 0u, 0u})), __builtin_bit_cast(bf16x8, ((u32x4){wp.x, wp.y, 0u, 0u})), ((f32x4){0.f, 0.f, 0.f, 0.f}));
                up[bb] = pack4bf(ub);
            }
#pragma unroll
            for (int t = 0; t < 2; ++t) *(LAS u32x2*)(Uvj + (16 * ntW + fr) * P + 16 * (mt0 + t) + 4 * fq) = (t == 0 ? (mt0 == 0 ? up[0] : up[2]) : (mt0 == 0 ? up[1] : up[3]));
            bf16x8 bR[2], bN[2];
#pragma unroll
            for (int ks = 0; ks < 2; ++ks) { bR[ks] = FR(Rt, 16 * ntW + fr, ks); bN[ks] = FR(NkT, 16 * ntW + fr, ks); }
#pragma unroll
            for (int t = 0; t < 2; ++t) {
                const int mt = mt0 + t;
                f32x4 yy = (f32x4){0.f, 0.f, 0.f, 0.f};
#pragma unroll
                for (int ks = 0; ks < 2; ++ks) { yy = MFMA16(FR(Svk, 16 * mt + fr, ks), bR[ks], yy); yy = MFMA16(FR(Vvj, 16 * mt + fr, ks), bN[ks], yy); }
                y0[t] = yy;
            }
        }
        LDS_BARRIER();
        {
            int tl_ = tid; asm volatile("" : "+v"(tl_)); const int lane = tl_ & 63, fr = lane & 15, fq = lane >> 4, tau = tl_ >> 3, oct = tl_ & 7; (void)lane; (void)fr; (void)fq; (void)tau; (void)oct;
            bf16x8 bNb[2], bU[2], bV[2];
#pragma unroll
            for (int ks = 0; ks < 2; ++ks) { bNb[ks] = FR(NbT, 16 * ntW + fr, ks); bU[ks] = FR(Uvj, 16 * ntW + fr, ks); bV[ks] = FR(Vvj, 16 * ntW + fr, ks); }
            const int tt = 16 * ntW + fr;
            const int tq = r ? T - 1 - (64 * ci + tt) : 64 * ci + tt;
            bf16* yrow = YS + ((size_t)r * M + rowbase + tq) * 384 + 64 * h;
#pragma unroll
            for (int t = 0; t < 2; ++t) {
                const int mt = mt0 + t;
                f32x4 yy = y0[t];
#pragma unroll
                for (int ks = 0; ks < 2; ++ks) yy = MFMA16(FR(Uvj, 16 * mt + fr, ks), bNb[ks], yy);
                *(u32x2*)(yrow + 16 * mt + 4 * fq) = pack4bf(yy);
                f32x4 sacc = Sacc[t];
#pragma unroll
                for (int ks = 0; ks < 2; ++ks) { sacc = MFMA16(FR(Bkj, 16 * mt + fr, ks), bU[ks], sacc); sacc = MFMA16(FR(Kkj, 16 * mt + fr, ks), bV[ks], sacc); }
                sacc = sacc * *(const LAS f32x4*)(DL + 16 * mt + 4 * fq);
                Sacc[t] = sacc;
            }
        }
        LDS_BARRIER();
        {
            int tl_ = tid; asm volatile("" : "+v"(tl_)); const int fr = tl_ & 15, fq = (tl_ & 63) >> 4;
#pragma unroll
            for (int t = 0; t < 2; ++t) *(LAS u32x2*)(Svk + (16 * ntW + fr) * P + 16 * (mt0 + t) + 4 * fq) = pack4bf(Sacc[t]);
        }
    }
#undef FR
#undef RW_LOAD
#undef UNPK
#undef MIX8
    if (sout_idx >= 0) {
        float* Sout = Sout_base + (size_t)sout_idx * 4096;
        int tl_ = tid; asm volatile("" : "+v"(tl_)); const int fr = tl_ & 15, fq = (tl_ & 63) >> 4;
#pragma unroll
        for (int t = 0; t < 2; ++t) *(f32x4*)(Sout + (16 * ntW + fr) * 64 + 16 * (mt0 + t) + 4 * fq) = Sacc[t];
    }
    LDS_BARRIER();
}

__device__ __forceinline__ void fin_stage_g2(LAS unsigned char* lds, const float* g2, int tid) {
    LAS bf16* G2T = (LAS bf16*)lds;
    for (int e = tid; e < 384 * 16; e += NTHR) {
        const int c = e % 384, jo = e / 384;
        float a[8];
#pragma unroll
        for (int j = 0; j < 8; ++j) a[j] = g2[(size_t)(8 * jo + j) * 384 + c];
        u32x4 w; w.x = pk2(a[0], a[1]); w.y = pk2(a[2], a[3]); w.z = pk2(a[4], a[5]); w.w = pk2(a[6], a[7]); *(LAS u32x4*)(G2T + c * 136 + 8 * jo) = w;
    }
}
__device__ __forceinline__ void unit_fin(LAS unsigned char* lds, bf16* Z, const bf16* HS, const bf16* YS, const float* BON, const float* mu, const float* ln_g, const float* out_g, int ft, int tid) {
    constexpr int PG = 136;
    LAS bf16* G2T = (LAS bf16*)lds;
    LAS bf16* SGb = G2T + 384 * PG;
    const int wave = __builtin_amdgcn_readfirstlane(tid >> 6), lane = tid & 63, fr = lane & 15, fq = lane >> 4;
    {
        const int tau = tid >> 3, oct = tid & 7;
        const size_t m = (size_t)ft * 64 + tau;
        const int tq = m < MCTX ? (int)(m & (TCTX - 1)) : (int)((m - MCTX) & (TLAT - 1)); const int T = m < MCTX ? TCTX : TLAT;
        const bf16* zr = Z + m * ZP;
#pragma unroll
        for (int hf = 0; hf < 2; ++hf) {
            float x[8]; shiftmix8(zr, OFF_C + 1408 + 16 * oct + 8 * hf, tq > 0, tq < T - 1, mu, x);
            u32x4 w; w.x = pk2(sigmoidf_(x[0]), sigmoidf_(x[1])); w.y = pk2(sigmoidf_(x[2]), sigmoidf_(x[3])); w.z = pk2(sigmoidf_(x[4]), sigmoidf_(x[5])); w.w = pk2(sigmoidf_(x[6]), sigmoidf_(x[7]));
            *(LAS u32x4*)(SGb + tau * PG + 16 * oct + 8 * hf) = w;
        }
    }
    __syncthreads();
    const int nt = wave & 3, h0 = 3 * (wave >> 2);
    const int tau = 16 * nt + fr;
    const size_t m = (size_t)ft * 64 + tau;
    const int tq = m < MCTX ? (int)(m & (TCTX - 1)) : (int)((m - MCTX) & (TLAT - 1)); const int T = m < MCTX ? TCTX : TLAT;
    const bool hasp = tq > 0, hasn = tq < T - 1;
    bf16* zr = Z + m * ZP;
    bf16x8 bsg[4];
#pragma unroll
    for (int ks = 0; ks < 4; ++ks) bsg[ks] = *(const LAS bf16x8*)(SGb + tau * PG + 32 * ks + 8 * fq);
#pragma unroll 1
    for (int hh = 0; hh < 3; ++hh) {
        const int h = h0 + hh;
        f32x4 g[4];
#pragma unroll
        for (int ct = 0; ct < 4; ++ct) { g[ct] = (f32x4){0.f, 0.f, 0.f, 0.f};
#pragma unroll
            for (int ks = 0; ks < 4; ++ks) g[ct] = MFMA16(*(const LAS bf16x8*)(G2T + (64 * h + 16 * ct + fr) * PG + 32 * ks + 8 * fq), bsg[ks], g[ct]); }
        const float bon = BON[((size_t)0 * M + m) * 8 + h] + BON[((size_t)1 * M + m) * 8 + h];
        {
            float y[4][4]; float s = 0.f;
#pragma unroll
            for (int ct = 0; ct < 4; ++ct) { const int c = 64 * h + 16 * ct + 4 * fq;
                const u32x2 a = *(const u32x2*)(YS + ((size_t)0 * M + m) * 384 + c), b = *(const u32x2*)(YS + ((size_t)1 * M + m) * 384 + c);
                y[ct][0] = __uint_as_float(a.x << 16) + __uint_as_float(b.x << 16); y[ct][1] = __uint_as_float(a.x & 0xffff0000u) + __uint_as_float(b.x & 0xffff0000u);
                y[ct][2] = __uint_as_float(a.y << 16) + __uint_as_float(b.y << 16); y[ct][3] = __uint_as_float(a.y & 0xffff0000u) + __uint_as_float(b.y & 0xffff0000u);
                s += (y[ct][0] + y[ct][1]) + (y[ct][2] + y[ct][3]); }
            s += bperm(s, lane ^ 16); s += bperm(s, lane ^ 32);
            const float mean = s * (1.f / 64.f); float q = 0.f;
#pragma unroll
            for (int ct = 0; ct < 4; ++ct)
#pragma unroll
                for (int i = 0; i < 4; ++i) { y[ct][i] -= mean; q += y[ct][i] * y[ct][i]; }
            q += bperm(q, lane ^ 16); q += bperm(q, lane ^ 32);
            const float rstd = rsqrtf(q * (1.f / 64.f) + 1e-5f);
#pragma unroll
            for (int ct = 0; ct < 4; ++ct) { const int c = 64 * h + 16 * ct + 4 * fq;
                const f32x4 lg = *(const f32x4*)(ln_g + c), mv = *(const f32x4*)(mu + 768 + c);
                const int col = OFF_C + 768 + c;
                const u32x2 vc = *(const u32x2*)(zr + col); u32x2 vp = (u32x2){0u, 0u}, vn = (u32x2){0u, 0u};
                if (hasp) vp = *(const u32x2*)(zr - ZP + col);
                if (hasn) vn = *(const u32x2*)(zr + ZP + col);
                const float cv[4] = {__uint_as_float(vc.x << 16), __uint_as_float(vc.x & 0xffff0000u), __uint_as_float(vc.y << 16), __uint_as_float(vc.y & 0xffff0000u)};
                const float pv[4] = {__uint_as_float(vp.x << 16), __uint_as_float(vp.x & 0xffff0000u), __uint_as_float(vp.y << 16), __uint_as_float(vp.y & 0xffff0000u)};
                const float nv[4] = {__uint_as_float(vn.x << 16), __uint_as_float(vn.x & 0xffff0000u), __uint_as_float(vn.y << 16), __uint_as_float(vn.y & 0xffff0000u)};
                f32x4 o;
#pragma unroll
                for (int i = 0; i < 4; ++i) { const float vs = cv[i] + mv[i] * (0.5f * (pv[i] + nv[i]) - cv[i]); o[i] = (y[ct][i] * rstd * lg[i] + bon * vs) * g[ct][i]; }
                *(u32x2*)(zr + YC_OFF + c) = pack4bf(o); }
        }
        {
            float y[4][4]; float s = 0.f;
#pragma unroll
            for (int ct = 0; ct < 4; ++ct) { const int c = 64 * h + 16 * ct + 4 * fq;
                const u32x2 a = *(const u32x2*)(HS + ((size_t)0 * M + m) * 384 + c), b = *(const u32x2*)(HS + ((size_t)1 * M + m) * 384 + c);
                y[ct][0] = __uint_as_float(a.x << 16) + __uint_as_float(b.x << 16); y[ct][1] = __uint_as_float(a.x & 0xffff0000u) + __uint_as_float(b.x & 0xffff0000u);
                y[ct][2] = __uint_as_float(a.y << 16) + __uint_as_float(b.y << 16); y[ct][3] = __uint_as_float(a.y & 0xffff0000u) + __uint_as_float(b.y & 0xffff0000u);
                s += (y[ct][0] + y[ct][1]) + (y[ct][2] + y[ct][3]); }
            s += bperm(s, lane ^ 16); s += bperm(s, lane ^ 32);
            const float mean = s * (1.f / 64.f); float q = 0.f;
#pragma unroll
            for (int ct = 0; ct < 4; ++ct)
#pragma unroll
                for (int i = 0; i < 4; ++i) { y[ct][i] -= mean; q += y[ct][i] * y[ct][i]; }
            q += bperm(q, lane ^ 16); q += bperm(q, lane ^ 32);
            const float rstd = rsqrtf(q * (1.f / 64.f) + 1e-5f);
#pragma unroll
            for (int ct = 0; ct < 4; ++ct) { const int c = 64 * h + 16 * ct + 4 * fq;
                const f32x4 og = *(const f32x4*)(out_g + c);
                const u32x2 ov = *(const u32x2*)(zr + OFF_O + c);
                const float oo[4] = {__uint_as_float(ov.x << 16), __uint_as_float(ov.x & 0xffff0000u), __uint_as_float(ov.y << 16), __uint_as_float(ov.y & 0xffff0000u)};
                f32x4 o;
#pragma unroll
                for (int i = 0; i < 4; ++i) o[i] = y[ct][i] * rstd * og[i] * sigmoidf_(oo[i]);
                *(u32x2*)(zr + YB_OFF + c) = pack4bf(o); }
        }
    }
    __syncthreads();
}

constexpr int NR = 96, NC = 160;
constexpr size_t XNC_OFF = (size_t)2 * M * 384 * 2;
constexpr size_t HIDC_BACK = 2 * MiB;
static_assert(XNC_OFF + (size_t)MCTX * D * 2 + HIDC_BACK <= (size_t)M * D * 2 && (size_t)MCTX * FF * 2 == HIDC_BACK + (size_t)MCTX * ZP * 2, "context overlays");
#define PHASE_TID() int tid; asm volatile("v_mbcnt_lo_u32_b32 %0, -1, 0\n\tv_mbcnt_hi_u32_b32 %0, -1, %0" : "=v"(tid)); tid += wave0 * 64; \
    const int lane = tid & 63, wave = __builtin_amdgcn_readfirstlane(tid >> 6); (void)lane; (void)wave
struct Args { const float* in[33]; float* out; unsigned char* ws; int pad0, pad1; };
static_assert(sizeof(Args) == 33 * 8 + 8 + 8 + 8, "Args has no padding");

__global__ void __launch_bounds__(NTHR, 2) fwd(Args args) {
    extern __shared__ __attribute__((aligned(16))) unsigned char lds_raw[];
    LAS unsigned char* lds = (LAS unsigned char*)lds_raw;
    volatile LAS unsigned* MISC = (volatile LAS unsigned*)(lds + MISC_OFF);
    const int tid0 = threadIdx.x;
    const int wave0 = __builtin_amdgcn_readfirstlane(tid0 >> 6);
    const int G = gridDim.x, bid = blockIdx.x;
    const bool isR = bid < NR;
    unsigned char* ws = args.ws;
    unsigned* ctl = (unsigned*)(ws + WS_CTL);
    float* MOD = (float*)(ws + WS_MOD);
    float* BON = (float*)(ws + WS_BON);
    bf16* ACT = (bf16*)(ws + WS_ACT);
    bf16* XNC = (bf16*)(ws + WS_ACT + XNC_OFF);
    bf16* Zb = (bf16*)(ws + WS_Z);
    bf16* YSb = (bf16*)(ws + WS_YS);
    bf16* HSb = ACT;
    bf16* HID = Zb;
    bf16* HIDC = (bf16*)(ws + WS_Z - HIDC_BACK);
    float* out = args.out;
    const float* x_prompt = args.in[0]; const float* x_sample = args.in[1];

    if (tid0 < 64) MISC[tid0] = 0u;
    __syncthreads();
    XcdBarrier gbar = xcd_barrier_post(ctl + CW_BAR, MISC + 8, (unsigned)G, true);
    XcdBarrier cbar = xcd_barrier_post(ctl + CW_BAR + XCD_BAR_WORDS, MISC + 10, (unsigned)NC, !isR);

    enum { K_W = 0, K_N1 = 1, K_IN = 2, K_Q = 3, K_FIN = 4, K_OUT = 5, K_N2 = 6, K_UP = 7, K_DOWN = 8, K_FINAL = 9 };
    for (int st = 0; st < 28; ++st) {
        int kind, l, rows, grp, seam;
        switch (st) {
            case 0:  kind = K_W;    l = 0; rows = 0; grp = 0; seam = 1; break;
            case 1:  kind = K_N1;   l = 0; rows = 0; grp = 0; seam = 1; break;
            case 2:  kind = K_IN;   l = 0; rows = 0; grp = 0; seam = 1; break;
            case 3:  kind = K_Q;    l = 0; rows = 1; grp = 2; seam = 2; break;
            case 4:  kind = K_FIN;  l = 0; rows = 1; grp = 1; seam = 2; break;
            case 5:  kind = K_OUT;  l = 0; rows = 1; grp = 1; seam = 2; break;
            case 6:  kind = K_N2;   l = 0; rows = 1; grp = 1; seam = 2; break;
            case 7:  kind = K_UP;   l = 0; rows = 1; grp = 1; seam = 1; break;
            case 8:  kind = K_FIN;  l = 0; rows = 2; grp = 0; seam = 1; break;
            case 9:  kind = K_OUT;  l = 0; rows = 2; grp = 0; seam = 1; break;
            case 10: kind = K_N2;   l = 0; rows = 2; grp = 0; seam = 1; break;
            case 11: kind = K_UP;   l = 0; rows = 2; grp = 0; seam = 1; break;
            case 12: kind = K_DOWN; l = 0; rows = 2; grp = 0; seam = 1; break;
            case 13: kind = K_N1;   l = 1; rows = 2; grp = 0; seam = 1; break;
            case 14: kind = K_IN;   l = 1; rows = 2; grp = 3; seam = 1; break;
            case 15: kind = K_N1;   l = 1; rows = 1; grp = 0; seam = 1; break;
            case 16: kind = K_IN;   l = 1; rows = 1; grp = 0; seam = 1; break;
            case 17: kind = K_Q;    l = 1; rows = 1; grp = 2; seam = 2; break;
            case 18: kind = K_FIN;  l = 1; rows = 1; grp = 1; seam = 2; break;
            case 19: kind = K_OUT;  l = 1; rows = 1; grp = 1; seam = 2; break;
            case 20: kind = K_N2;   l = 1; rows = 1; grp = 1; seam = 2; break;
            case 21: kind = K_UP;   l = 1; rows = 1; grp = 1; seam = 1; break;
            case 22: kind = K_FIN;  l = 1; rows = 2; grp = 3; seam = 1; break;
            case 23: kind = K_OUT;  l = 1; rows = 2; grp = 0; seam = 1; break;
            case 24: kind = K_N2;   l = 1; rows = 2; grp = 0; seam = 1; break;
            case 25: kind = K_UP;   l = 1; rows = 2; grp = 0; seam = 1; break;
            case 26: kind = K_DOWN; l = 1; rows = 2; grp = 0; seam = 1; break;
            default: kind = K_FINAL; l = 1; rows = 0; grp = 0; seam = 0; break;
        }
        int Gs = G, cb = bid; bool active = true;
        if (grp == 1) { Gs = NC; cb = bid - NR; active = !isR; }
        else if (grp == 2) { Gs = NC; cb = bid - NR; }
        else if (grp == 3) { if (bid < 64) { kind = K_DOWN; rows = 1; Gs = 64; cb = bid; if (st == 14) l = 0; } else { Gs = G - 64; cb = bid - 64; } }
        const int pm0 = rows == 2 ? 16 : 0, mtl = rows == 0 ? 80 : (rows == 1 ? 16 : 64);
        const int m_lo = pm0 * 256, m_hi = m_lo + mtl * 256;
        bf16* XNg = rows == 0 ? ACT : (rows == 2 ? ACT - (size_t)MCTX * D : XNC);
        const bf16* XNa = rows == 1 ? XNC : ACT;
        if (active) {
            const float* MODl = MOD + (size_t)l * NMODC * 6144;
            if (kind == K_W) {
                PHASE_TID();
                const int vcu = (G % 8 == 0) ? (bid % 8) * (G / 8) + bid / 8 : bid;
                phase_weights(lds, args.in[12], args.in[13], args.in[30], args.in[31], ws + WS_W, vcu * NWAVES + wave, WI_IN, G * NWAVES, wave, lane);
                __syncthreads(); phase_mod(lds, args.in[2], args.in[7], args.in[10], args.in[11], MOD, tid, bid, G);
            } else if (kind == K_N1) {
                PHASE_TID();
                phase_norm(l == 0 ? x_prompt : out, l == 0 ? x_sample : out + (size_t)MCTX * D, args.in[8] + l * D, MODl, 0, 1024, XNg, m_lo, m_hi, cb * NWAVES + wave, Gs * NWAVES, lane);
            } else if (kind == K_FINAL) {
                PHASE_TID();
                phase_final_norm(out, args.in[32], m_lo, m_hi, cb * NWAVES + wave, Gs * NWAVES, lane);
            } else if (kind == K_IN) {
                PHASE_TID();
                pg8::Gemm g{XNa, (const bf16*)(ws + WS_W + WOFF_IN), mtl * 256, ZP, D, D}; pg8::StaticOrder S; S.init(mtl * 256, ZP, Gs, cb);
                pg8::EpiBf16<0> E{Zb + (size_t)m_lo * ZP, ZP};
                pg8::gemm_phase<pg8::EpiBf16<0>, pg8::StaticOrder, true, true>(lds, g, S, E, tid);
            } else if (kind == K_Q) {
                unsigned* counter = ctl + CW_WORK + 64 * l;
                const int nwu = l == 0 ? (WI_ALL + 31) / 32 : (WI_ALL - WI_IN + 31) / 32, wbase = l == 0 ? 0 : WI_IN;
                const int ulim = 1120 + nwu;
                for (;;) {
                    int u;
                    if (isR) u = bid;
                    else {
                        __syncthreads();
                        { int t0_; asm volatile("v_mbcnt_lo_u32_b32 %0, -1, 0\n\tv_mbcnt_hi_u32_b32 %0, -1, %0" : "=v"(t0_));
                          if (wave0 == 0 && t0_ == 0) MISC[0] = __hip_atomic_fetch_add(counter, 1u, __ATOMIC_RELAXED, __HIP_MEMORY_SCOPE_AGENT); }
                        __syncthreads();
                        u = (int)MISC[0];
                        if (u >= ulim) break;
                    }
                    int tu; asm volatile("v_mbcnt_lo_u32_b32 %0, -1, 0\n\tv_mbcnt_hi_u32_b32 %0, -1, %0" : "=v"(tu)); tu += wave0 * 64;
                    if (isR || u < 480) {
                        const bool lat = isR || u < 96; const bool is_rwkv = isR || (u >= 96 && u < 288);
                        const int idx = isR ? u : (u < 96 ? u : (u < 288 ? u - 96 : u - 288));
                        const int b = idx / 12, rem = idx % 12, r = rem / 6, h = rem % 6;
                        const int T = lat ? TLAT : TCTX; const int rowbase = lat ? MCTX + b * TLAT : b * TCTX;
                        if (is_rwkv) {
                            const float* S0 = lat ? args.in[6] + ((((size_t)b * DEPTH + l) * 2 + r) * 6 + h) * 4096 : nullptr;
                            const int sout_idx = lat ? -1 : (((b * DEPTH + l) * 2 + r) * 6 + h);
                            unit_rwkv(lds, Zb, YSb, BON, args.in[20] + l * 1536, args.in[21] + l * 768, args.in[22] + (size_t)l * 2 * 64 * 384, args.in[23] + l * 768, args.in[24] + (size_t)l * 2 * 64 * 384,
                                      args.in[26] + l * 384, args.in[27] + l * 384, args.in[28] + l * 384, S0, out + (size_t)M * D + 1572864 + 24576 + 384, sout_idx, rowbase, T, r, h, tu);
                        } else {
                            const size_t sidx = (((size_t)b * DEPTH + l) * 2 + r) * 6 + h;
                            const float* C0 = lat ? args.in[3] + sidx * 4096 : nullptr; const float* n0 = lat ? args.in[4] + sidx * 64 : nullptr; const float* m0 = lat ? args.in[5] + sidx : nullptr;
                            float* Cout = lat ? nullptr : out + (size_t)M * D + sidx * 4096; float* nout = lat ? nullptr : out + (size_t)M * D + 1572864 + sidx * 64; float* mout = lat ? nullptr : out + (size_t)M * D + 1572864 + 24576 + sidx;
                            unit_mlstm(lds, Zb, HSb, args.in[17] + l * 3 * 768, args.in[18] + l * 24, C0, n0, m0, Cout, nout, mout, rowbase, T, r, h, tu);
                        }
                    } else if (u >= 1120) {
                        const int base = wbase + 32 * (u - 1120);
                        const int wv = __builtin_amdgcn_readfirstlane(tu >> 6);
                        phase_weights(lds, args.in[12] + (size_t)(l + 1 < DEPTH ? l + 1 : l) * D * INC, args.in[13] + (size_t)l * D * D, args.in[30] + (size_t)l * D * FF, args.in[31] + (size_t)l * FF * D, ws + WS_W,
                                      base + wv, (base + 32 < WI_ALL ? base + 32 : WI_ALL), 8, wv, tu & 63);
                    } else {
                        const int idx = u - 480;
                        unit_gmlp(lds, Zb, args.in[14] + l * 256, args.in[15] + (size_t)l * 4 * 128 * 128, args.in[16] + l * 4 * 128, idx >> 2, idx & 3, tu);
                    }
                    if (isR) break;
                }
            } else if (kind == K_FIN) {
                PHASE_TID();
                fin_stage_g2(lds, args.in[25] + (size_t)l * 128 * 384, tid);
                for (int ft = m_lo / 64 + cb; ft < m_hi / 64; ft += Gs)
                    unit_fin(lds, Zb, HSb, YSb, BON, args.in[20] + l * 1536, args.in[29] + l * 384, args.in[19] + l * 384, ft, tid);
            } else if (kind == K_OUT) {
                PHASE_TID();
                pg8::Gemm g{Zb + (size_t)m_lo * ZP, (const bf16*)(ws + WS_W + WOFF_OUT), mtl * 256, D, D, ZP}; pg8::StaticOrder S; S.init(mtl * 256, D, Gs, cb);
                pg8::EpiRes E{l == 0 ? x_prompt : out, l == 0 ? x_sample : out + (size_t)MCTX * D, out, MODl + 2048, pm0};
                pg8::gemm_phase<pg8::EpiRes, pg8::StaticOrder, true, true>(lds, g, S, E, tid);
            } else if (kind == K_N2) {
                PHASE_TID();
                phase_norm(out, out + (size_t)MCTX * D, args.in[9] + l * D, MODl, 3072, 4096, XNg, m_lo, m_hi, cb * NWAVES + wave, Gs * NWAVES, lane);
            } else if (kind == K_UP) {
                PHASE_TID();
                pg8::Gemm g{XNa, (const bf16*)(ws + WS_W + WOFF_W1), mtl * 256, FF, D, D}; pg8::StaticOrder S; S.init(mtl * 256, FF, Gs, cb);
                pg8::EpiBf16<2> E{rows == 1 ? HIDC : HID + (size_t)m_lo * FF, FF};
                pg8::gemm_phase<pg8::EpiBf16<2>, pg8::StaticOrder, true, true>(lds, g, S, E, tid);
            } else {
                PHASE_TID();
                pg8::Gemm g{rows == 1 ? HIDC : HID + (size_t)m_lo * FF, (const bf16*)(ws + WS_W + WOFF_W2), mtl * 256, D, FF, FF}; pg8::StaticOrder S; S.init(mtl * 256, D, Gs, cb);
                pg8::EpiRes E{out, out + (size_t)MCTX * D, out, MODl + 5120, pm0};
                pg8::gemm_phase<pg8::EpiRes, pg8::StaticOrder, true, true>(lds, g, S, E, tid);
            }
        }
        if (seam == 2) { if (!isR) xcd_barrier(cbar); }
        else if (seam == 1) xcd_barrier(gbar);
    }
}

extern "C" void kernel_launch(void* const* d_in, const int* in_sizes, int n_in, void* d_out, int out_size, void* d_ws, size_t ws_size, hipStream_t stream) {
    static int grid = 0;
    if (grid == 0) {
        if (n_in != 33 || ws_size < WS_END || out_size != M * D + 1572864 + 24576 + 384 + 1572864) { fprintf(stderr, "kernel_launch: unexpected problem (n_in %d, out %d, ws %zu)\n", n_in, out_size, ws_size); grid = -1; return; }
        int dev = 0, cus = 0;
        if (hipGetDevice(&dev) != hipSuccess || hipDeviceGetAttribute(&cus, hipDeviceAttributeMultiprocessorCount, dev) != hipSuccess) { grid = -1; return; }
        if (hipFuncSetAttribute((const void*)fwd, hipFuncAttributeMaxDynamicSharedMemorySize, LDS_BYTES) != hipSuccess) { fprintf(stderr, "kernel_launch: hipFuncSetAttribute failed\n"); grid = -1; return; }
        (void)hipGetLastError();
        grid = cus;
        if (grid != NR + NC) { fprintf(stderr, "kernel_launch: built for %d CUs\n", NR + NC); grid = -1; return; }
    }
    if (grid < 0) return;
    (void)hipMemsetAsync((char*)d_ws + WS_CTL, 0, CTL_ZERO_BYTES, stream);
    Args a{};
    for (int i = 0; i < 33; ++i) a.in[i] = (const float*)d_in[i];
    a.out = (float*)d_out; a.ws = (unsigned char*)d_ws;
    hipLaunchKernelGGL(fwd, dim3(grid), dim3(NTHR), LDS_BYTES, stream, a);
}
```
